# Optimizing an MI355X kernel written in HIP

```python
import math
import jax, jax.numpy as jnp
from jax import lax
import numpy as np

D_MODEL = 2048
BATCH = 8
SEQ = 2048
DEPTH = 1

CHUNK = 64
Q_BLOCK = 128
SB_HEADS = 8
SB_HEAD_DIM = 128
SB_WIDTH = SB_HEADS * SB_HEAD_DIM
DA_HEADS = 8
DA_HEAD_DIM = 64
DA_V_DIM = 2 * DA_HEAD_DIM
DA_QK_WIDTH = DA_HEADS * 2 * DA_HEAD_DIM
DA_WIDTH = DA_HEADS * DA_V_DIM
N_BRANCHES = 2
IN_COLS = 3 * SB_WIDTH + 2 * DA_QK_WIDTH + DA_WIDTH + N_BRANCHES * D_MODEL
ROPE_THETA = 10000.0
N_GROUPS = 4
EXPERTS_PER_GROUP = 8
N_EXPERTS = N_GROUPS * EXPERTS_PER_GROUP
TOP_K_IN_GROUP = 2
D_EXPERT = D_MODEL // 4
MOE_BLOCK = 128
EPS = 1e-6

kernel_name = "hybrid_stickbreak_diffattn_hiermoe"


def rmsnorm(x, g):
    xf = x.astype(jnp.float32)
    y = xf * lax.rsqrt(jnp.mean(xf * xf, axis=-1, keepdims=True) + EPS)
    return (y * g.astype(jnp.float32)).astype(x.dtype)


def to_heads(t, n_heads, head_dim):
    b, s, _ = t.shape
    return t.reshape(b, s, n_heads, head_dim).transpose(0, 2, 1, 3)


def rope(x, pos):
    d = x.shape[-1]
    half = d // 2
    inv_freq = ROPE_THETA ** (-(jnp.arange(half, dtype=jnp.float32) * 2.0 / d))
    ang = pos.astype(jnp.float32)[:, None] * inv_freq[None, :]
    cos, sin = jnp.cos(ang), jnp.sin(ang)
    xf = x.astype(jnp.float32)
    x1, x2 = xf[..., :half], xf[..., half:]
    return jnp.concatenate([x1 * cos - x2 * sin, x2 * cos + x1 * sin], axis=-1).astype(x.dtype)


def stick_breaking_block(q, k, v, t0):
    qb, L, d = q.shape[2], k.shape[2], q.shape[3]
    z = jnp.einsum('bhqd,bhkd->bhqk', q, k).astype(jnp.float32) / math.sqrt(d)
    t = t0 + jnp.arange(qb)
    s = jnp.arange(L)
    mask = s[None, :] < t[:, None]
    log_1m = jnp.where(mask, jax.nn.log_sigmoid(-z), 0.0)
    suffix = lax.cumsum(log_1m, axis=3, reverse=True) - log_1m
    a = jnp.where(mask, jnp.exp(jax.nn.log_sigmoid(z) + suffix), 0.0)
    return jnp.einsum('bhqk,bhkd->bhqd', a.astype(v.dtype), v)


def diff_attn_block(q1, q2, k1, k2, v, t0, lam):
    qb, L, d = q1.shape[2], k1.shape[2], q1.shape[3]
    t = t0 + jnp.arange(qb)
    s = jnp.arange(L)
    mask = (s // CHUNK)[None, :] <= (t // CHUNK)[:, None]

    def probs(q, k):
        sc = jnp.einsum('bhqd,bhkd->bhqk', q, k).astype(jnp.float32) / math.sqrt(d)
        return jax.nn.softmax(jnp.where(mask, sc, -jnp.inf), axis=-1)

    attn = probs(q1, k1) - lam * probs(q2, k2)
    return jnp.einsum('bhqk,bhkd->bhqd', attn.astype(v.dtype), v)


def hierarchical_moe(h, w_group_router, w_expert_router, w_gate, w_up, w_down):
    b, s, d = h.shape
    n = b * s
    hf = h.reshape(n, d)
    g_logits = (hf @ w_group_router).astype(jnp.float32)
    g_prob = jax.nn.softmax(g_logits, axis=-1)
    grp = jnp.argmax(g_logits, axis=-1)
    p_grp = jnp.take_along_axis(g_prob, grp[:, None], axis=1)
    e_logits = (hf @ w_expert_router).astype(jnp.float32).reshape(n, N_GROUPS, EXPERTS_PER_GROUP)
    idx = jnp.broadcast_to(grp[:, None, None], (n, 1, EXPERTS_PER_GROUP))
    e_sel = jnp.take_along_axis(e_logits, idx, axis=1)[:, 0]
    top_val, top_idx = lax.top_k(e_sel, TOP_K_IN_GROUP)
    gate = p_grp * jax.nn.softmax(top_val, axis=-1)
    expert = grp[:, None] * EXPERTS_PER_GROUP + top_idx

    a_total = n * TOP_K_IN_GROUP
    e_flat = expert.reshape(a_total)
    tok_flat = jnp.repeat(jnp.arange(n, dtype=jnp.int32), TOP_K_IN_GROUP)
    w_flat = gate.reshape(a_total)
    order = jnp.argsort(e_flat)
    e_sorted, tok_sorted, w_sorted = e_flat[order], tok_flat[order], w_flat[order]
    counts = jnp.zeros((N_EXPERTS,), jnp.int32).at[e_flat].add(1)
    padded = (counts + MOE_BLOCK - 1) // MOE_BLOCK * MOE_BLOCK
    starts = jnp.cumsum(counts) - counts
    pad_ends = jnp.cumsum(padded)
    pad_starts = pad_ends - padded
    dest = pad_starts[e_sorted] + jnp.arange(a_total, dtype=jnp.int32) - starts[e_sorted]
    n_blocks = -(-a_total // MOE_BLOCK) + N_EXPERTS
    p_rows = n_blocks * MOE_BLOCK
    buf_tok = jnp.full((p_rows,), n, jnp.int32).at[dest].set(tok_sorted)
    buf_w = jnp.zeros((p_rows,), jnp.float32).at[dest].set(w_sorted)
    block_expert = jnp.minimum(
        jnp.searchsorted(pad_ends, jnp.arange(n_blocks, dtype=jnp.int32) * MOE_BLOCK, side='right'),
        N_EXPERTS - 1)
    h_pad = jnp.concatenate([hf, jnp.zeros((1, d), hf.dtype)], axis=0)
    xb = h_pad[buf_tok].reshape(n_blocks, MOE_BLOCK, d)

    def expert_block(args):
        xblk, e = args
        return (jax.nn.silu(xblk @ w_gate[e]) * (xblk @ w_up[e])) @ w_down[e]

    yb = lax.map(expert_block, (xb, block_expert)).reshape(p_rows, d)
    y = jnp.zeros((n + 1, d), h.dtype).at[buf_tok].add(yb * buf_w[:, None].astype(h.dtype))
    return y[:n].reshape(b, s, d)


def setup_inputs(seed: int = 0) -> dict:
    key = jax.random.key(seed)
    ks = jax.random.split(key, 20)
    f32 = jnp.float32

    def nrm(k, shape, scale):
        return jax.random.normal(k, shape, f32) * scale

    def gain(k, shape):
        return 1.0 + 0.02 * jax.random.normal(k, shape, f32)

    return {
        "x": nrm(ks[0], (BATCH, SEQ, D_MODEL), 1.0),
        "mix_norm_g": gain(ks[1], (DEPTH, D_MODEL)),
        "w_in": nrm(ks[2], (DEPTH, D_MODEL, IN_COLS), D_MODEL ** -0.5),
        "lambda_q1": nrm(ks[3], (DEPTH, DA_HEAD_DIM), 0.1),
        "lambda_k1": nrm(ks[4], (DEPTH, DA_HEAD_DIM), 0.1),
        "lambda_q2": nrm(ks[5], (DEPTH, DA_HEAD_DIM), 0.1),
        "lambda_k2": nrm(ks[6], (DEPTH, DA_HEAD_DIM), 0.1),
        "diff_subnorm_g": gain(ks[7], (DEPTH, DA_V_DIM)),
        "w_branch_sb": nrm(ks[8], (DEPTH, SB_WIDTH, D_MODEL), SB_WIDTH ** -0.5),
        "w_branch_diff": nrm(ks[9], (DEPTH, DA_WIDTH, D_MODEL), DA_WIDTH ** -0.5),
        "w_out": nrm(ks[10], (DEPTH, D_MODEL, D_MODEL), D_MODEL ** -0.5),
        "ffn_norm_g": gain(ks[11], (DEPTH, D_MODEL)),
        "w_group_router": nrm(ks[12], (DEPTH, D_MODEL, N_GROUPS), D_MODEL ** -0.5),
        "w_expert_router": nrm(ks[13], (DEPTH, D_MODEL, N_EXPERTS), D_MODEL ** -0.5),
        "w_gate": nrm(ks[14], (DEPTH, N_EXPERTS, D_MODEL, D_EXPERT), D_MODEL ** -0.5),
        "w_up": nrm(ks[15], (DEPTH, N_EXPERTS, D_MODEL, D_EXPERT), D_MODEL ** -0.5),
        "w_down": nrm(ks[16], (DEPTH, N_EXPERTS, D_EXPERT, D_MODEL), D_EXPERT ** -0.5),
        "final_norm_g": gain(ks[17], (D_MODEL,)),
    }


def reference(x, mix_norm_g, w_in, lambda_q1, lambda_k1, lambda_q2, lambda_k2, diff_subnorm_g,
              w_branch_sb, w_branch_diff, w_out, ffn_norm_g, w_group_router, w_expert_router,
              w_gate, w_up, w_down, final_norm_g):
    b, s, _ = x.shape
    pos = jnp.arange(s, dtype=jnp.int32)
    split_at = list(np.cumsum([SB_WIDTH, SB_WIDTH, SB_WIDTH, DA_QK_WIDTH, DA_QK_WIDTH, DA_WIDTH, D_MODEL]))
    for l in range(DEPTH):
        h = rmsnorm(x, mix_norm_g[l])
        proj = h @ w_in[l]
        q_sb, k_sb, v_sb, q_da, k_da, v_da, g_sb, g_da = jnp.split(proj, split_at, axis=-1)
        q_sb = to_heads(q_sb, SB_HEADS, SB_HEAD_DIM)
        k_sb = to_heads(k_sb, SB_HEADS, SB_HEAD_DIM)
        v_sb = to_heads(v_sb, SB_HEADS, SB_HEAD_DIM)
        q_da = to_heads(q_da, DA_HEADS, 2 * DA_HEAD_DIM)
        k_da = to_heads(k_da, DA_HEADS, 2 * DA_HEAD_DIM)
        v_da = to_heads(v_da, DA_HEADS, DA_V_DIM)
        q1 = rope(q_da[..., :DA_HEAD_DIM], pos)
        q2 = rope(q_da[..., DA_HEAD_DIM:], pos)
        k1 = rope(k_da[..., :DA_HEAD_DIM], pos)
        k2 = rope(k_da[..., DA_HEAD_DIM:], pos)
        lam_init = 0.8 - 0.6 * math.exp(-0.3 * l)
        lam = (jnp.exp(jnp.sum(lambda_q1[l].astype(jnp.float32) * lambda_k1[l].astype(jnp.float32)))
               - jnp.exp(jnp.sum(lambda_q2[l].astype(jnp.float32) * lambda_k2[l].astype(jnp.float32)))
               + lam_init)

        sb_blocks, da_blocks = [], []
        for i in range(s // Q_BLOCK):
            t0, t1 = i * Q_BLOCK, (i + 1) * Q_BLOCK
            sb_blocks.append(stick_breaking_block(q_sb[:, :, t0:t1], k_sb[:, :, :t1], v_sb[:, :, :t1], t0))
            da_blocks.append(diff_attn_block(q1[:, :, t0:t1], q2[:, :, t0:t1], k1[:, :, :t1], k2[:, :, :t1],
                                             v_da[:, :, :t1], t0, lam))
        o_sb = jnp.concatenate(sb_blocks, axis=2).transpose(0, 2, 1, 3).reshape(b, s, SB_WIDTH)
        o_da = rmsnorm(jnp.concatenate(da_blocks, axis=2), diff_subnorm_g[l]) * (1.0 - lam_init)
        o_da = o_da.transpose(0, 2, 1, 3).reshape(b, s, DA_WIDTH)

        merged = (jax.nn.sigmoid(g_sb) * (o_sb @ w_branch_sb[l])
                  + jax.nn.sigmoid(g_da) * (o_da @ w_branch_diff[l]))
        x = x + merged @ w_out[l]

        h2 = rmsnorm(x, ffn_norm_g[l])
        x = x + hierarchical_moe(h2, w_group_router[l], w_expert_router[l], w_gate[l], w_up[l], w_down[l])
    return rmsnorm(x, final_norm_g)
```

```cpp
#include <hip/hip_runtime.h>
#include <cstdio>
#include <cstdint>

#ifndef DBG_STAGE
#define DBG_STAGE 0
#endif

#ifndef PH_MASK
#define PH_MASK 0x3ff
#endif
#define PH(k) ((PH_MASK >> (k)) & 1)
#ifndef REP_LIST
#define REP_LIST 1, 1, 1, 1, 1, 1, 1, 1, 1, 1
#endif
#ifndef REP_SB
#define REP_SB 1
#endif
#ifndef REP_DA
#define REP_DA 1
#endif
constexpr int kReps[10] = {REP_LIST};
#define DI __device__ __forceinline__
#define LAS __attribute__((address_space(3)))
#define GAS __attribute__((address_space(1)))
typedef unsigned short bf16_t;
typedef short bf16x8 __attribute__((ext_vector_type(8)));
typedef short s16x4 __attribute__((ext_vector_type(4)));
typedef float f32x2 __attribute__((ext_vector_type(2)));
typedef float f32x4 __attribute__((ext_vector_type(4)));
typedef float f32x16 __attribute__((ext_vector_type(16)));
typedef unsigned u32x2 __attribute__((ext_vector_type(2)));
typedef unsigned u32x4 __attribute__((ext_vector_type(4)));
typedef __bf16 bf16x2_t __attribute__((ext_vector_type(2)));

constexpr int DM = 2048, NTOK = 16384, SEQ = 2048, INC = 10240, NEXP = 32, DE = 512;
constexpr int PROWS = 40960;
constexpr float EPS = 1e-6f;
constexpr float LOG2E = 1.4426950408889634f;
constexpr float C_SB = LOG2E * 0.08838834764831845f;
constexpr float C_DA = LOG2E * 0.125f;

DI unsigned cvtpk(float lo, float hi) { f32x2 v = {lo, hi}; bf16x2_t b = __builtin_convertvector(v, bf16x2_t); return __builtin_bit_cast(unsigned, b); }
DI float bf2f(unsigned short b) { return __builtin_bit_cast(float, (unsigned)b << 16); }
DI float bflo(unsigned w) { return __builtin_bit_cast(float, w << 16); }
DI float bfhi(unsigned w) { return __builtin_bit_cast(float, w & 0xffff0000u); }
DI float fexp2(float x) { return __builtin_amdgcn_exp2f(x); }
DI float flog2(float x) { return __builtin_amdgcn_logf(x); }
DI float frcp(float x) { return __builtin_amdgcn_rcpf(x); }
DI float wave_sum(float v) {
#pragma unroll
    for (int o = 1; o < 64; o <<= 1) v += __shfl_xor(v, o);
    return v;
}

namespace pg8 {
constexpr int BM = 256, BK = 64, HALF = 128, HTB = HALF * BK * 2, STAGE_BYTES = 8 * HTB, NXCD = 8, WGM = 8;
__host__ __device__ __forceinline__ int lds_byte(int r, int c) { const int st = (r >> 4) * 2 + (c >> 5), rr = r & 15, cc = c & 31, ob = rr * 64 + cc * 2; return st * 1024 + (ob ^ (((ob >> 9) & 1) << 5)); }
__host__ __device__ __forceinline__ void stage_rc(int b, int& R, int& C) { const int st = b / 1024, sb = b % 1024, swz = sb ^ (((sb >> 9) & 1) << 5); R = (st >> 1) * 16 + swz / 64; C = (st & 1) * 32 + (swz % 64) / 2; }
__host__ __device__ __forceinline__ int perm32(int rho) { const int n = rho >> 4, i = rho & 15; return 8 * (i >> 2) + 4 * n + (i & 3); }

struct Unit { int pm, pn, bt; };
struct Gemm { const bf16_t* A; const bf16_t* Bt; int M, N, K; };

struct StaticOrder {
    int nM, nN, nwg, G, c;
    __host__ __device__ void init(int M, int N, int G_, int c_) { nM = M / BM; nN = N / BM; nwg = nM * nN; G = G_; c = c_; }
    __host__ __device__ bool next(int i, Unit& u) const {
        const long L = (long)i * G + c; if (L >= nwg) return false;
        int wgid = (int)L; { const int q = nwg / NXCD, r = nwg % NXCD, xcd = wgid % NXCD, off = wgid / NXCD; wgid = (xcd < r ? xcd * (q + 1) : r * (q + 1) + (xcd - r) * q) + off; }
        const int nig = WGM * nN, gid = wgid / nig, fm = gid * WGM, gsz = (nM - fm) < WGM ? (nM - fm) : WGM;
        u.pm = fm + ((wgid % nig) % gsz); u.pn = (wgid % nig) / gsz; u.bt = u.pn; return true;
    }
};
struct MoeOrder {
    const LAS int* tstart; int npn, G, c;
    DI bool next(int i, Unit& u) const {
        const int total = tstart[32] * npn;
        const long L = (long)i * G + c;
        const bool ok = L < total;
        int tile = ok ? (int)L / npn : 0, pn = ok ? (int)L % npn : 0, e = 0;
#pragma unroll
        for (int k = 1; k < 32; ++k) e += (tstart[k] <= tile) ? 1 : 0;
        u.pm = __builtin_amdgcn_readfirstlane(tile); u.pn = __builtin_amdgcn_readfirstlane(pn); u.bt = __builtin_amdgcn_readfirstlane(e * npn + pn);
        return __builtin_amdgcn_readfirstlane((int)ok) != 0;
    }
};

template <class Epi, class Sched, bool ALIGN_EPI, bool SP2>
DI void gemm_phase(LAS unsigned char* lds, const Gemm g, const Sched& S, const Epi& E) {
    int tid = threadIdx.x; asm volatile("" : "+v"(tid));
    const int wid = __builtin_amdgcn_readfirstlane(tid >> 6), lane = tid & 63, wr = wid >> 2, wc = wid & 3, fr = lane & 15, fq = lane >> 4;
    const int K = g.K, nt = K / BK;
    unsigned voffA[2], voffB[2];
#pragma unroll
    for (int i = 0; i < 2; ++i) { int R, C; stage_rc(tid * 16 + i * 8192, R, C); const int Rb = Epi::PERM ? ((R & ~31) + perm32(R & 31)) : R;
        voffA[i] = (unsigned)(R * K + C) * 2u; voffB[i] = (unsigned)(Rb * K + C) * 2u; }
    const size_t kstep = (size_t)(BK * 2);
    const size_t hstep = (size_t)HALF * K * 2;
    const size_t tstep = 2 * hstep;
    const unsigned ldsw = (unsigned)wid * 1024u;
    const int aoff = lds_byte(wr * 64 + fr, fq * 8), boff = lds_byte(wc * 32 + fr, fq * 8);
#define PG8_SA(b, h) (((b) * 2 + (h)) * HTB)
#define PG8_SB(b, h) ((4 + (b) * 2 + (h)) * HTB)
#define PG8_STAGE(bufoff, gbase, voff) do { _Pragma("unroll") for (int _i = 0; _i < 2; ++_i) \
        __builtin_amdgcn_global_load_lds((const unsigned*)((const char*)(gbase) + (voff)[_i]), (LAS unsigned*)(lds + (bufoff) + ldsw + _i * 8192), 16, 0, 0); } while (0)
#define PG8_LDA(dst, b, h) do { _Pragma("unroll") for (int m = 0; m < 4; ++m) _Pragma("unroll") for (int k = 0; k < 2; ++k) dst[m][k] = *(const LAS bf16x8*)(lds + PG8_SA(b, h) + aoff + m * 2048 + k * 1024); } while (0)
#define PG8_LDB(dst, b, h) do { _Pragma("unroll") for (int n = 0; n < 2; ++n) _Pragma("unroll") for (int k = 0; k < 2; ++k) dst[n][k] = *(const LAS bf16x8*)(lds + PG8_SB(b, h) + boff + n * 2048 + k * 1024); } while (0)
#define PG8_MMA(ai, bj, At, Bt) do { __builtin_amdgcn_s_setprio(1); _Pragma("unroll") for (int m = 0; m < 4; ++m) _Pragma("unroll") for (int n = 0; n < 2; ++n) _Pragma("unroll") for (int k = 0; k < 2; ++k) \
        acc[ai][bj][m][n] = __builtin_amdgcn_mfma_f32_16x16x32_bf16(Bt[n][k], At[m][k], acc[ai][bj][m][n], 0, 0, 0); __builtin_amdgcn_s_setprio(0); } while (0)
#define PG8_WAIT_V(n) asm volatile("s_waitcnt vmcnt(" #n ")" ::: "memory")
#define PG8_WAIT_L(n) asm volatile("s_waitcnt lgkmcnt(" #n ")" ::: "memory")
#define PG8_BAR __builtin_amdgcn_s_barrier()
#define PG8_SCHED __builtin_amdgcn_sched_barrier(0)
    Unit cur, nxt; int ui = 0;
    if (!S.next(0, cur)) return;
    f32x4 acc[2][2][4][2];
#pragma unroll
    for (int a = 0; a < 2; ++a)
#pragma unroll
        for (int b = 0; b < 2; ++b)
#pragma unroll
            for (int m = 0; m < 4; ++m)
#pragma unroll
                for (int n = 0; n < 2; ++n) acc[a][b][m][n] = (f32x4){0.f, 0.f, 0.f, 0.f};
    bf16x8 At[4][2], B0[2][2], B1[2][2];
    const char* cA = (const char*)g.A + (size_t)cur.pm * tstep; const char* cB = (const char*)g.Bt + (size_t)cur.bt * tstep;
    if constexpr (SP2) {
        PG8_STAGE(PG8_SB(0, 0), cB, voffB); PG8_STAGE(PG8_SB(0, 1), cB + hstep, voffB); PG8_STAGE(PG8_SA(0, 0), cA, voffA); PG8_STAGE(PG8_SA(0, 1), cA + hstep, voffA);
        if (wr == 1) PG8_BAR;
        PG8_WAIT_V(2); PG8_BAR;
        PG8_STAGE(PG8_SB(1, 0), cB + kstep, voffB); PG8_STAGE(PG8_SA(1, 0), cA + kstep, voffA); PG8_STAGE(PG8_SB(1, 1), cB + hstep + kstep, voffB);
        PG8_WAIT_V(6); PG8_BAR;
    } else {
        PG8_STAGE(PG8_SB(0, 0), cB, voffB); PG8_STAGE(PG8_SA(0, 0), cA, voffA); PG8_STAGE(PG8_SB(0, 1), cB + hstep, voffB); PG8_STAGE(PG8_SA(0, 1), cA + hstep, voffA);
        if (wr == 1) PG8_BAR;
        PG8_WAIT_V(4); PG8_BAR;
        PG8_STAGE(PG8_SB(1, 0), cB + kstep, voffB); PG8_STAGE(PG8_SA(1, 0), cA + kstep, voffA); PG8_STAGE(PG8_SB(1, 1), cB + hstep + kstep, voffB);
        PG8_WAIT_V(6); PG8_BAR;
    }
    for (;;) {
        const bool has_next = S.next(ui + 1, nxt);
        const char* nA = has_next ? (const char*)g.A + (size_t)nxt.pm * tstep : cA; const char* nB = has_next ? (const char*)g.Bt + (size_t)nxt.bt * tstep : cB;
        for (int t = 0; t < nt; t += 2) {
            const bool last = (t == nt - 2);
            const char* a1 = cA + (size_t)(t + 1) * kstep;
            const char* a2 = last ? nA : cA + (size_t)(t + 2) * kstep; const char* b2 = last ? nB : cB + (size_t)(t + 2) * kstep;
            const char* a3 = a2 + kstep; const char* b3 = b2 + kstep;
            if constexpr (Epi::HAS_MID) { if (t == Epi::MID_T) E.mid(acc, cur, wr, wc, fr, fq); }
            if constexpr (SP2) {
            PG8_LDB(B0, 0, 0); PG8_LDB(B1, 0, 1); PG8_SCHED; PG8_LDA(At, 0, 0); PG8_STAGE(PG8_SA(1, 1), a1 + hstep, voffA);
            PG8_WAIT_V(8); PG8_WAIT_L(0); PG8_BAR; PG8_MMA(0, 0, At, B0); PG8_MMA(0, 1, At, B1); PG8_BAR; PG8_SCHED;
            PG8_LDA(At, 0, 1); PG8_STAGE(PG8_SB(0, 0), b2, voffB); PG8_STAGE(PG8_SB(0, 1), b2 + hstep, voffB); PG8_STAGE(PG8_SA(0, 0), a2, voffA);
            PG8_WAIT_V(8); PG8_WAIT_L(0); PG8_BAR; PG8_MMA(1, 0, At, B0); PG8_MMA(1, 1, At, B1); PG8_BAR; PG8_SCHED;
            PG8_LDB(B0, 1, 0); PG8_LDB(B1, 1, 1); PG8_SCHED; PG8_LDA(At, 1, 0); PG8_STAGE(PG8_SA(0, 1), a2 + hstep, voffA);
            PG8_WAIT_V(8); PG8_WAIT_L(0); PG8_BAR; PG8_MMA(0, 0, At, B0); PG8_MMA(0, 1, At, B1); PG8_BAR; PG8_SCHED;
            PG8_LDA(At, 1, 1); PG8_STAGE(PG8_SB(1, 0), b3, voffB); PG8_STAGE(PG8_SB(1, 1), b3 + hstep, voffB); PG8_STAGE(PG8_SA(1, 0), a3, voffA);
            PG8_WAIT_V(8); PG8_WAIT_L(0); PG8_BAR; PG8_MMA(1, 0, At, B0); PG8_MMA(1, 1, At, B1); PG8_BAR; PG8_SCHED;
            } else {
            PG8_LDB(B0, 0, 0); PG8_SCHED; PG8_LDA(At, 0, 0); PG8_STAGE(PG8_SA(1, 1), a1 + hstep, voffA);
            PG8_WAIT_L(8); PG8_BAR; PG8_WAIT_L(0); PG8_MMA(0, 0, At, B0); PG8_BAR; PG8_SCHED;
            PG8_LDB(B1, 0, 1); PG8_STAGE(PG8_SB(0, 0), b2, voffB);
            PG8_BAR; PG8_WAIT_L(0); PG8_MMA(0, 1, At, B1); PG8_BAR;
            PG8_LDA(At, 0, 1); PG8_STAGE(PG8_SA(0, 0), a2, voffA);
            PG8_BAR; PG8_WAIT_L(0); PG8_MMA(1, 0, At, B0); PG8_BAR; PG8_SCHED;
            PG8_STAGE(PG8_SB(0, 1), b2 + hstep, voffB);
            PG8_WAIT_V(6); PG8_BAR; PG8_MMA(1, 1, At, B1); PG8_BAR;
            PG8_LDB(B0, 1, 0); PG8_SCHED; PG8_LDA(At, 1, 0); PG8_STAGE(PG8_SA(0, 1), a2 + hstep, voffA);
            PG8_WAIT_L(8); PG8_BAR; PG8_WAIT_L(0); PG8_MMA(0, 0, At, B0); PG8_BAR; PG8_SCHED;
            PG8_LDB(B1, 1, 1); PG8_STAGE(PG8_SB(1, 0), b3, voffB);
            PG8_BAR; PG8_WAIT_L(0); PG8_MMA(0, 1, At, B1); PG8_BAR;
            PG8_LDA(At, 1, 1); PG8_STAGE(PG8_SA(1, 0), a3, voffA);
            PG8_BAR; PG8_WAIT_L(0); PG8_MMA(1, 0, At, B0); PG8_BAR; PG8_SCHED;
            PG8_STAGE(PG8_SB(1, 1), b3 + hstep, voffB);
            PG8_WAIT_V(6); PG8_BAR; PG8_MMA(1, 1, At, B1); PG8_BAR;
            }
        }
        if constexpr (ALIGN_EPI) { if (wr == 0) PG8_BAR; }
        E(acc, cur, wr, wc, fr, fq);
        if (!has_next) break;
#pragma unroll
        for (int a = 0; a < 2; ++a)
#pragma unroll
            for (int b = 0; b < 2; ++b)
#pragma unroll
                for (int m = 0; m < 4; ++m)
#pragma unroll
                    for (int n = 0; n < 2; ++n) acc[a][b][m][n] = (f32x4){0.f, 0.f, 0.f, 0.f};
        cur = nxt; cA = nA; cB = nB; ++ui;
        if constexpr (ALIGN_EPI) { if (wr == 1) PG8_BAR; }
    }
    PG8_WAIT_V(0);
    if constexpr (!ALIGN_EPI) { if (wr == 0) PG8_BAR; }
    PG8_BAR;
#undef PG8_SA
#undef PG8_SB
#undef PG8_STAGE
#undef PG8_LDA
#undef PG8_LDB
#undef PG8_MMA
#undef PG8_WAIT_V
#undef PG8_WAIT_L
#undef PG8_BAR
#undef PG8_SCHED
}

typedef f32x4 Acc[2][2][4][2];
DI u32x4 pack8(const f32x4 a, const f32x4 b) { u32x4 w; w.x = cvtpk(a[0], a[1]); w.y = cvtpk(a[2], a[3]); w.z = cvtpk(b[0], b[1]); w.w = cvtpk(b[2], b[3]); return w; }

struct EpiInProj {
    static constexpr bool PERM = true, HAS_MID = false; static constexpr int MID_T = 0;
    bf16_t* qkv;
    bf16_t* gsb; bf16_t* gda;
    const f32x2* rope;
    DI void mid(Acc&, const Unit&, int, int, int, int) const {}
    DI void operator()(const Acc& acc, const Unit& u, int wr, int wc, int fr, int fq) const {
 asm volatile("" : "+v"(fr), "+v"(fq));
               const int pn = u.pn, row0 = u.pm * BM + wr * 64 + fr;
        if (pn >= 24) {
            bf16_t* dst = (pn < 32) ? gsb : gda; const int col0 = ((pn - 24) & 7) * 256 + wc * 32 + 8 * fq;
#pragma unroll
            for (int ai = 0; ai < 2; ++ai)
#pragma unroll
                for (int m = 0; m < 4; ++m) { bf16_t* rowp = dst + (size_t)(row0 + ai * HALF + m * 16) * 2048 + col0;
#pragma unroll
                    for (int bj = 0; bj < 2; ++bj) { f32x4 v0 = acc[ai][bj][m][0], v1 = acc[ai][bj][m][1];
#pragma unroll
                        for (int j = 0; j < 4; ++j) { v0[j] = frcp(1.f + fexp2(-LOG2E * v0[j])); v1[j] = frcp(1.f + fexp2(-LOG2E * v1[j])); }
                        *(u32x4*)(rowp + bj * HALF) = pack8(v0, v1); } }
        } else if (pn >= 12 && pn < 20) {
            const int tsel = (pn < 16) ? 3 : 4; const float sc = (pn < 16) ? C_DA : 1.f;
            bf16_t* dst = qkv + (size_t)tsel * NTOK * 1024; const int col0 = ((pn - 12) & 3) * 256 + wc * 64 + 8 * fq;
#pragma unroll
            for (int ai = 0; ai < 2; ++ai)
#pragma unroll
                for (int m = 0; m < 4; ++m) { const int row = row0 + ai * HALF + m * 16; const int pos = row & (SEQ - 1);
                    const f32x4* cs = (const f32x4*)(rope + (size_t)pos * 32 + 8 * fq);
                    f32x4 lo[2], hi[2];
#pragma unroll
                    for (int n = 0; n < 2; ++n) { const f32x4 c0 = cs[2 * n], c1 = cs[2 * n + 1]; const f32x4 xl = acc[ai][0][m][n], xh = acc[ai][1][m][n];
                        const float co[4] = {c0[0], c0[2], c1[0], c1[2]}, si[4] = {c0[1], c0[3], c1[1], c1[3]};
#pragma unroll
                        for (int j = 0; j < 4; ++j) { lo[n][j] = (xl[j] * co[j] - xh[j] * si[j]) * sc; hi[n][j] = (xh[j] * co[j] + xl[j] * si[j]) * sc; } }
                    bf16_t* rowp = dst + (size_t)row * 1024 + col0;
                    *(u32x4*)(rowp) = pack8(lo[0], lo[1]); *(u32x4*)(rowp + 32) = pack8(hi[0], hi[1]); }
        } else {
            const int tsel = (pn < 12) ? (pn >> 2) : 5; const float sc = (pn < 4) ? C_SB : 1.f;
            bf16_t* dst = qkv + (size_t)tsel * NTOK * 1024; const int col0 = (pn & 3) * 256 + wc * 32 + 8 * fq;
#pragma unroll
            for (int ai = 0; ai < 2; ++ai)
#pragma unroll
                for (int m = 0; m < 4; ++m) { bf16_t* rowp = dst + (size_t)(row0 + ai * HALF + m * 16) * 1024 + col0;
#pragma unroll
                    for (int bj = 0; bj < 2; ++bj) *(u32x4*)(rowp + bj * HALF) = pack8(acc[ai][bj][m][0] * sc, acc[ai][bj][m][1] * sc); }
        }
    }
};

struct EpiMerged {
    static constexpr bool PERM = true, HAS_MID = true; static constexpr int MID_T = 16;
    const bf16_t* gsb; const bf16_t* gda; bf16_t* merged;
    DI void mid(Acc& acc, const Unit& u, int wr, int wc, int fr, int fq) const {
 asm volatile("" : "+v"(fr), "+v"(fq));
               const int row0 = u.pm * BM + wr * 64 + fr, col0 = u.pn * BM + wc * 32 + 8 * fq;
#pragma unroll
        for (int ai = 0; ai < 2; ++ai)
#pragma unroll
            for (int m = 0; m < 4; ++m) { const size_t off = (size_t)(row0 + ai * HALF + m * 16) * 2048 + col0;
#pragma unroll
                for (int bj = 0; bj < 2; ++bj) { const u32x4 a = *(const u32x4*)(gsb + off + bj * HALF), b = *(const u32x4*)(gda + off + bj * HALF);
#pragma unroll
                    for (int w = 0; w < 4; ++w) { const float r0 = bflo(a[w]) * frcp(fmaxf(bflo(b[w]), 1e-30f)), r1 = bfhi(a[w]) * frcp(fmaxf(bfhi(b[w]), 1e-30f));
                        acc[ai][bj][m][w >> 1][(w & 1) * 2] *= r0; acc[ai][bj][m][w >> 1][(w & 1) * 2 + 1] *= r1; }
                    asm volatile("" ::: "memory"); } }
    }
    DI void operator()(const Acc& acc, const Unit& u, int wr, int wc, int fr, int fq) const {
 asm volatile("" : "+v"(fr), "+v"(fq));
               const int row0 = u.pm * BM + wr * 64 + fr, col0 = u.pn * BM + wc * 32 + 8 * fq;
#pragma unroll
        for (int ai = 0; ai < 2; ++ai)
#pragma unroll
            for (int m = 0; m < 4; ++m) { const size_t off = (size_t)(row0 + ai * HALF + m * 16) * 2048 + col0;
#pragma unroll
                for (int bj = 0; bj < 2; ++bj) { const u32x4 b = *(const u32x4*)(gda + off + bj * HALF); f32x4 v0 = acc[ai][bj][m][0], v1 = acc[ai][bj][m][1];
                    v0[0] *= bflo(b[0]); v0[1] *= bfhi(b[0]); v0[2] *= bflo(b[1]); v0[3] *= bfhi(b[1]); v1[0] *= bflo(b[2]); v1[1] *= bfhi(b[2]); v1[2] *= bflo(b[3]); v1[3] *= bfhi(b[3]);
                    *(u32x4*)(merged + off + bj * HALF) = pack8(v0, v1); } }
    }
};

struct EpiX1 {
    static constexpr bool PERM = true, HAS_MID = false; static constexpr int MID_T = 0;
    const float* x; bf16_t* x1b; float* ssq;
    DI void mid(Acc&, const Unit&, int, int, int, int) const {}
    DI void operator()(const Acc& acc, const Unit& u, int wr, int wc, int fr, int fq) const {
 asm volatile("" : "+v"(fr), "+v"(fq));
               const int row0 = u.pm * BM + wr * 64 + fr, col0 = u.pn * BM + wc * 32 + 8 * fq;
#pragma unroll
        for (int ai = 0; ai < 2; ++ai)
#pragma unroll
            for (int m = 0; m < 4; ++m) { const int row = row0 + ai * HALF + m * 16; const size_t off = (size_t)row * 2048 + col0; float s = 0.f;
#pragma unroll
                for (int bj = 0; bj < 2; ++bj) { const f32x4 x0 = *(const f32x4*)(x + off + bj * HALF), x1 = *(const f32x4*)(x + off + bj * HALF + 4);
                    const f32x4 v0 = acc[ai][bj][m][0] + x0, v1 = acc[ai][bj][m][1] + x1;
                    s += (v0[0] * v0[0] + v0[1] * v0[1]) + (v0[2] * v0[2] + v0[3] * v0[3]) + (v1[0] * v1[0] + v1[1] * v1[1]) + (v1[2] * v1[2] + v1[3] * v1[3]);
                    *(u32x4*)(x1b + off + bj * HALF) = pack8(v0, v1); }
                s += __shfl_xor(s, 16); s += __shfl_xor(s, 32);
                if (fq == 0) ssq[(size_t)row * 32 + u.pn * 4 + wc] = s; }
    }
};

struct EpiSwiglu {
    static constexpr bool PERM = true, HAS_MID = false; static constexpr int MID_T = 0;
    bf16_t* H;
    DI void mid(Acc&, const Unit&, int, int, int, int) const {}
    DI void operator()(const Acc& acc, const Unit& u, int wr, int wc, int fr, int fq) const {
 asm volatile("" : "+v"(fr), "+v"(fq));
               const int row0 = u.pm * BM + wr * 64 + fr, col0 = u.pn * HALF + wc * 32 + 8 * fq;
#pragma unroll
        for (int ai = 0; ai < 2; ++ai)
#pragma unroll
            for (int m = 0; m < 4; ++m) { f32x4 h[2];
#pragma unroll
                for (int n = 0; n < 2; ++n)
#pragma unroll
                    for (int j = 0; j < 4; ++j) { const float gt = acc[ai][0][m][n][j], up = acc[ai][1][m][n][j]; h[n][j] = gt * up * frcp(1.f + fexp2(-LOG2E * gt)); }
                *(u32x4*)(H + (size_t)(row0 + ai * HALF + m * 16) * DE + col0) = pack8(h[0], h[1]); }
    }
};

struct EpiDown {
    static constexpr bool PERM = true, HAS_MID = false; static constexpr int MID_T = 0;
    const float* rowgate; bf16_t* Y;
    DI void mid(Acc&, const Unit&, int, int, int, int) const {}
    DI void operator()(const Acc& acc, const Unit& u, int wr, int wc, int fr, int fq) const {
 asm volatile("" : "+v"(fr), "+v"(fq));
               const int row0 = u.pm * BM + wr * 64 + fr, col0 = u.pn * BM + wc * 32 + 8 * fq;
#pragma unroll
        for (int ai = 0; ai < 2; ++ai)
#pragma unroll
            for (int m = 0; m < 4; ++m) { const int row = row0 + ai * HALF + m * 16; const float gw = rowgate[row];
#pragma unroll
                for (int bj = 0; bj < 2; ++bj) *(u32x4*)(Y + (size_t)row * 2048 + col0 + bj * HALF) = pack8(acc[ai][bj][m][0] * gw, acc[ai][bj][m][1] * gw); }
    }
};
}

namespace att {
#define MFMA32(a, b, c) __builtin_amdgcn_mfma_f32_32x32x16_bf16((a), (b), (c), 0, 0, 0)
DI int crow(int r, int h) { return (r & 3) + 8 * (r >> 2) + 4 * h; }
DI int img_off(int row, int ch) { return 256 * row + 16 * (ch ^ (((row & 3) << 2) | ((row >> 2) & 3))); }
constexpr int L_K = 0, L_V = 16384, L_STG = 32768, L_WSF = 98304;
typedef short v4i16_t __attribute__((ext_vector_type(4)));
DI s16x4 tr16(const LAS unsigned char* p) { return __builtin_bit_cast(s16x4, __builtin_amdgcn_ds_read_tr16_b64_v4i16((LAS v4i16_t*)p)); }
DI float xhalf_sum(float v) { auto rr = __builtin_amdgcn_permlane32_swap(__float_as_uint(v), __float_as_uint(v), false, false); return __uint_as_float(rr[0]) + __uint_as_float(rr[1]); }
DI float xhalf_max(float v) { auto rr = __builtin_amdgcn_permlane32_swap(__float_as_uint(v), __float_as_uint(v), false, false); return fmaxf(__uint_as_float(rr[0]), __uint_as_float(rr[1])); }

struct TileRegs { u32x4 k[2], v[2]; };
DI void tile_load(TileRegs& R, const bf16_t* Kp, const bf16_t* Vp, int key0, int tid) {
#pragma unroll
    for (int i = 0; i < 2; ++i) { const int c = tid + 512 * i, row = c >> 4, ch = c & 15;
        R.k[i] = *(const u32x4*)(Kp + (size_t)(key0 + row) * 1024 + ch * 8); R.v[i] = *(const u32x4*)(Vp + (size_t)(key0 + row) * 1024 + ch * 8); }
}
DI void tile_store(const TileRegs& R, LAS unsigned char* lds, int tid) {
#pragma unroll
    for (int i = 0; i < 2; ++i) { const int c = tid + 512 * i, row = c >> 4, ch = c & 15; const int o = img_off(row, ch);
        *(LAS u32x4*)(lds + L_K + o) = R.k[i]; *(LAS u32x4*)(lds + L_V + o) = R.v[i]; }
}
template <int S0, int NS> DI f32x16 qk(const LAS unsigned char* kimg, const bf16x8 (&qf)[8], int sub, int r, int h) {
    f32x16 s = {};
    const int row = 32 * sub + r, f = ((r & 3) << 2) | ((r >> 2) & 3);
#pragma unroll
    for (int st = S0; st < S0 + NS; ++st) { const bf16x8 kf = *(const LAS bf16x8*)(kimg + 256 * row + 16 * ((2 * st + h) ^ f)); s = MFMA32(kf, qf[st], s); }
    return s;
}
DI bf16x8 vfrag(const LAS unsigned char* vimg, int vb  , int cx  , int q, int n, int sub, int s) {
    const int ch = (((n ^ q) << 2) | cx) * 16;
    const s16x4 lo = tr16(vimg + vb + ch + 256 * (32 * sub + 16 * s));
    const s16x4 hi = tr16(vimg + vb + (ch ^ 32) + 256 * (32 * sub + 16 * s + 8));
    return __builtin_shufflevector(lo, hi, 0, 1, 2, 3, 4, 5, 6, 7);
}
DI bf16x8 pack_p(const f32x16& p, int s) { u32x4 w; w.x = cvtpk(p[8 * s], p[8 * s + 1]); w.y = cvtpk(p[8 * s + 2], p[8 * s + 3]); w.z = cvtpk(p[8 * s + 4], p[8 * s + 5]); w.w = cvtpk(p[8 * s + 6], p[8 * s + 7]); return __builtin_bit_cast(bf16x8, w); }

DI void store_tile(const f32x16 (&o)[4], LAS unsigned char* stg, bf16_t* dst  , int ldo, int lane, int r, int h) {
#pragma unroll
    for (int i = 0; i < 16; ++i) { const int q = crow(i, h);
#pragma unroll
        for (int n = 0; n < 4; ++n) { const unsigned w = cvtpk(o[n][i], 0.f); *(LAS unsigned short*)(stg + q * 256 + (32 * n + r) * 2) = (unsigned short)w; } }
    asm volatile("s_waitcnt lgkmcnt(0)" ::: "memory");
#pragma unroll
    for (int it = 0; it < 8; ++it) { const int idx = it * 64 + lane, row = idx >> 4, ch = idx & 15; const u32x4 v = *(const LAS u32x4*)(stg + row * 256 + ch * 16);
        *(u32x4*)(dst + (size_t)row * ldo + ch * 8) = v; }
    asm volatile("s_waitcnt lgkmcnt(0)" ::: "memory");
}

DI void sb_unit(LAS unsigned char* lds, const bf16_t* Q, const bf16_t* K, const bf16_t* V, bf16_t* O  , int b, int hd, int qb) {
    int tid = threadIdx.x; asm volatile("" : "+v"(tid));
    const int lane = tid & 63, r = lane & 31, h = lane >> 5, wid = __builtin_amdgcn_readfirstlane(tid >> 6);
    const size_t rowbase = (size_t)b * SEQ; const int t0 = qb * 256;
    const bf16_t* Kp = K + rowbase * 1024 + hd * 128; const bf16_t* Vp = V + rowbase * 1024 + hd * 128;
    bf16x8 qf[8];
    { const bf16_t* qrow = Q + (rowbase + t0 + 32 * wid + r) * 1024 + hd * 128 + 8 * h;
#pragma unroll
      for (int st = 0; st < 8; ++st) qf[st] = *(const bf16x8*)(qrow + 16 * st); }
    const int i16 = lane & 15, q4 = i16 >> 2, p4 = i16 & 3, gi = (lane >> 4) & 1;
    const int vb = 256 * (4 * h + q4) + 8 * (p4 & 1), cx = (2 * gi + (p4 >> 1)) ^ h;
    f32x16 o[4];
#pragma unroll
    for (int n = 0; n < 4; ++n) o[n] = (f32x16){};
    float carry = 0.f;
    const int jmax = 4 * qb + 3, mysub = 8 * qb + wid;
    TileRegs R; tile_load(R, Kp, Vp, 64 * jmax, tid);
    for (int j = jmax; j >= 0; --j) {
        __syncthreads();
        tile_store(R, lds, tid);
        __syncthreads();
        if (j > 0) tile_load(R, Kp, Vp, 64 * (j - 1), tid);
#pragma unroll
        for (int sub = 1; sub >= 0; --sub) {
            const int su = 2 * j + sub;
            if (su <= mysub) {
                const f32x16 s = qk<0, 8>(lds + L_K, qf, sub, r, h);
                const bool diag = (su == mysub);
                float Lg[16], lb[16];
#pragma unroll
                for (int i = 0; i < 16; ++i) { const float zt = s[i], lg = flog2(1.f + fexp2(-fabsf(zt)));
                    Lg[i] = -(fmaxf(zt, 0.f) + lg); lb[i] = fminf(zt, 0.f) - lg;
                    if (diag && !(crow(i, h) < r)) { Lg[i] = 0.f; lb[i] = -1e30f; } }
                float T[4], sfx[16];
#pragma unroll
                for (int g = 0; g < 4; ++g) { sfx[4 * g + 3] = 0.f; sfx[4 * g + 2] = Lg[4 * g + 3]; sfx[4 * g + 1] = sfx[4 * g + 2] + Lg[4 * g + 2]; sfx[4 * g] = sfx[4 * g + 1] + Lg[4 * g + 1]; T[g] = sfx[4 * g] + Lg[4 * g]; }
                float both[4], thi[4];
#pragma unroll
                for (int g = 0; g < 4; ++g) { auto rr = __builtin_amdgcn_permlane32_swap(__float_as_uint(T[g]), __float_as_uint(T[g]), false, false);
                    thi[g] = __uint_as_float(rr[1]); both[g] = __uint_as_float(rr[0]) + thi[g]; }
                float G[4]; G[3] = 0.f; G[2] = both[3]; G[1] = G[2] + both[2]; G[0] = G[1] + both[1];
                f32x16 a;
#pragma unroll
                for (int g = 0; g < 4; ++g) { const float base = carry + G[g] + (h == 0 ? thi[g] : 0.f);
#pragma unroll
                    for (int c = 0; c < 4; ++c) a[4 * g + c] = fexp2(lb[4 * g + c] + sfx[4 * g + c] + base); }
                carry += G[0] + both[0];
                const bf16x8 p0 = pack_p(a, 0), p1 = pack_p(a, 1);
#pragma unroll
                for (int n = 0; n < 4; ++n) { o[n] = MFMA32(p0, vfrag(lds + L_V, vb, cx, q4, n, sub, 0), o[n]); o[n] = MFMA32(p1, vfrag(lds + L_V, vb, cx, q4, n, sub, 1), o[n]); }
            }
        }
    }
    store_tile(o, lds + L_STG + wid * 8192, O + (rowbase + t0 + 32 * wid) * 2048 + hd * 128, 2048, lane, r, h);
}

DI void da_rescale(f32x16 (&o)[4], LAS float* wsf, float f, int r, int h) {
    if (h == 0) wsf[r] = f;
    asm volatile("s_waitcnt lgkmcnt(0)" ::: "memory");
#pragma unroll
    for (int i = 0; i < 16; ++i) { const float fi = wsf[crow(i, h)];
#pragma unroll
        for (int n = 0; n < 4; ++n) o[n][i] *= fi; }
    asm volatile("s_waitcnt lgkmcnt(0)" ::: "memory");
}
DI void da_softmax(f32x16& s, float& m, float& l, f32x16 (&o)[4], LAS float* wsf, int r, int h) {
    float rm = fmaxf(fmaxf(s[0], s[1]), fmaxf(s[2], s[3]));
#pragma unroll
    for (int i = 4; i < 16; i += 4) rm = fmaxf(rm, fmaxf(fmaxf(s[i], s[i + 1]), fmaxf(s[i + 2], s[i + 3])));
    rm = xhalf_max(rm);
    if (__any(rm > m + 8.f)) { const float mn = fmaxf(m, rm), f = fexp2(m - mn); m = mn; l *= f; da_rescale(o, wsf, f, r, h); }
    float acc = 0.f;
#pragma unroll
    for (int i = 0; i < 16; ++i) { s[i] = fexp2(s[i] - m); acc += s[i]; }
    l += acc;
}
DI void da_unit(LAS unsigned char* lds, const bf16_t* Q, const bf16_t* K, const bf16_t* V, bf16_t* O  , const float* subg, float lam, int b, int hd, int qb  ) {
    int tid = threadIdx.x; asm volatile("" : "+v"(tid));
    const int lane = tid & 63, r = lane & 31, h = lane >> 5, wid = __builtin_amdgcn_readfirstlane(tid >> 6), g = wid >> 1, mp = wid & 1;
    const size_t rowbase = (size_t)b * SEQ; const int t0 = qb * 128;
    const bf16_t* Kp = K + rowbase * 1024 + hd * 128; const bf16_t* Vp = V + rowbase * 1024 + hd * 128;
    bf16x8 qf[8];
    { const bf16_t* qrow = Q + (rowbase + t0 + 32 * g + r) * 1024 + hd * 128 + 64 * mp + 8 * h;
#pragma unroll
      for (int st = 0; st < 4; ++st) { qf[st] = *(const bf16x8*)(qrow + 16 * st); qf[st + 4] = qf[st]; } }
    const int i16 = lane & 15, q4 = i16 >> 2, p4 = i16 & 3, gi = (lane >> 4) & 1;
    const int vb = 256 * (4 * h + q4) + 8 * (p4 & 1), cx = (2 * gi + (p4 >> 1)) ^ h;
    LAS float* wsf = (LAS float*)(lds + L_WSF + wid * 256);
    f32x16 o[4];
#pragma unroll
    for (int n = 0; n < 4; ++n) o[n] = (f32x16){};
    float m = -1e30f, l = 0.f;
    const int jlast = 2 * qb + 1, myj = 2 * qb + (g >> 1);
    TileRegs R; tile_load(R, Kp, Vp, 0, tid);
    for (int j = 0; j <= jlast; ++j) {
        __syncthreads();
        tile_store(R, lds, tid);
        __syncthreads();
        if (j < jlast) tile_load(R, Kp, Vp, 64 * (j + 1), tid);
        if (j <= myj) {
#pragma unroll
            for (int sub = 0; sub < 2; ++sub) {
                f32x16 s = mp ? qk<4, 4>(lds + L_K, qf, sub, r, h) : qk<0, 4>(lds + L_K, qf, sub, r, h);
                da_softmax(s, m, l, o, wsf, r, h);
                const bf16x8 p0 = pack_p(s, 0), p1 = pack_p(s, 1);
#pragma unroll
                for (int n = 0; n < 4; ++n) { o[n] = MFMA32(p0, vfrag(lds + L_V, vb, cx, q4, n, sub, 0), o[n]); o[n] = MFMA32(p1, vfrag(lds + L_V, vb, cx, q4, n, sub, 1), o[n]); }
            }
        }
    }
    l = xhalf_sum(l);
    if (h == 0) wsf[r] = (mp ? lam : 1.f) * frcp(l);
    asm volatile("s_waitcnt lgkmcnt(0)" ::: "memory");
#pragma unroll
    for (int i = 0; i < 16; ++i) { const float a = wsf[crow(i, h)];
#pragma unroll
        for (int n = 0; n < 4; ++n) o[n][i] *= a; }
    LAS float* stash = (LAS float*)(lds + L_STG + g * 16384);
    if (mp) {
#pragma unroll
        for (int i = 0; i < 16; ++i)
#pragma unroll
            for (int n = 0; n < 4; ++n) stash[(4 * i + n) * 64 + lane] = o[n][i];
    }
    __syncthreads();
    if (!mp) {
        float sg[4];
#pragma unroll
        for (int n = 0; n < 4; ++n) sg[n] = subg[32 * n + r] * 0.8f;
#pragma unroll
        for (int i = 0; i < 16; ++i) { float ss = 0.f;
#pragma unroll
            for (int n = 0; n < 4; ++n) { const float od = o[n][i] - stash[(4 * i + n) * 64 + lane]; o[n][i] = od; ss += od * od; }
            ss += __shfl_xor(ss, 1); ss += __shfl_xor(ss, 2); ss += __shfl_xor(ss, 4); ss += __shfl_xor(ss, 8); ss += __shfl_xor(ss, 16);
            const float rn = __builtin_amdgcn_rsqf(ss * (1.f / 128.f) + EPS);
#pragma unroll
            for (int n = 0; n < 4; ++n) o[n][i] *= rn * sg[n]; }
        asm volatile("s_waitcnt lgkmcnt(0)" ::: "memory");
        store_tile(o, lds + L_STG + g * 16384, O + (rowbase + t0 + 32 * g) * 2048 + 1024 + hd * 128, 2048, lane, r, h);
    }
}
}

constexpr size_t MiB = 1u << 20;
constexpr size_t WS_CTL = 0, CTL_ZERO_BYTES = 1 * MiB;
constexpr size_t WS_WINT = 1 * MiB;
constexpr size_t WS_WBRT = 41 * MiB;
constexpr size_t WS_WOUTT = 49 * MiB;
constexpr size_t WS_WGUT = 57 * MiB;
constexpr size_t WS_WDT = 185 * MiB;
constexpr size_t WS_WRT = 249 * MiB;
constexpr size_t WS_ROPE = 250 * MiB;
constexpr size_t WS_SSQ = 251 * MiB;
constexpr size_t WS_TOKINFO = 253 * MiB;
constexpr size_t WS_TOKW = WS_TOKINFO + 262144;
constexpr size_t WS_TOKPOS = WS_TOKW + 131072;
constexpr size_t WS_ROWGATE = WS_TOKPOS + 131072;
constexpr size_t WS_A = 254 * MiB;
constexpr size_t WS_B = 318 * MiB;
constexpr size_t WS_H = 478 * MiB;
constexpr size_t WS_END = 518 * MiB;
constexpr int CW_BAR = 4096, CW_CNT = 16384;

constexpr int RING_BYTES = 131072, LDSCTL_OFF = RING_BYTES, MISC_OFF = LDSCTL_OFF + 320, TST_OFF = LDSCTL_OFF + 512;
constexpr int LDS_BYTES = 147456;

#define RLX_AGENT __ATOMIC_RELAXED, __HIP_MEMORY_SCOPE_AGENT
#define LDS_WAIT() asm volatile("s_waitcnt lgkmcnt(0)" ::: "memory")

#define XB_TMO      128
#define XB_XCNT(j)  (256  + 64 * (j))
#define XB_XSUB(j)  (1280 + 64 * (j))
#define XB_XGEN(j)  (2304 + 64 * (j))
#define XB_TOP      3328
#define XB_TOPGEN   3392
#define XCD_BAR_WORDS 3456
#define XB_SPIN_CAP (1u << 18)
DI unsigned xb_ld(unsigned* p)              { return __hip_atomic_load(p, __ATOMIC_RELAXED, __HIP_MEMORY_SCOPE_AGENT); }
DI unsigned xb_add(unsigned* p, unsigned v) { return __hip_atomic_fetch_add(p, v, __ATOMIC_RELAXED, __HIP_MEMORY_SCOPE_AGENT); }
DI unsigned xb_xcc_id() { return (unsigned)__builtin_amdgcn_s_getreg((3 << 11) | 20) & 0xFu; }
#define XB_SPIN(cond, bar) do { unsigned _sp = 0; while (cond) { __builtin_amdgcn_s_sleep(1); \
    if ((++_sp & 255u) == 0u) { if (xb_ld(&(bar)[XB_TMO])) break; if (_sp > XB_SPIN_CAP) { atomicAdd(&(bar)[XB_TMO], 1u); break; } } } } while (0)
struct XcdBarrier { unsigned* bar; unsigned x; volatile LAS unsigned* st; };
DI XcdBarrier xcd_barrier_post(unsigned* bar, volatile LAS unsigned* st) {
    XcdBarrier b; b.bar = bar; b.x = xb_xcc_id(); b.st = st;
    if (threadIdx.x == 0) (void)xb_add(&bar[XB_XCNT(b.x)], 1u);
    return b;
}
DI void xcd_barrier_complete(unsigned* bar, unsigned x, unsigned& nloc, unsigned& nx) {
    const unsigned G = gridDim.x * gridDim.y * gridDim.z;
    unsigned sum, cnt, mine, sp = 0u;
    for (;;) {
        sum = 0u; cnt = 0u; mine = 0u;
#pragma unroll
        for (unsigned j = 0; j < 16; ++j) { const unsigned c = xb_ld(&bar[XB_XCNT(j)]); sum += c; cnt += (c > 0u) ? 1u : 0u; mine = (j == x) ? c : mine; }
        if (sum == G) break;
        __builtin_amdgcn_s_sleep(1);
        if ((++sp & 255u) == 0u) { if (xb_ld(&bar[XB_TMO])) break; if (sp > XB_SPIN_CAP) { atomicAdd(&bar[XB_TMO], 1u); break; } }
    }
    nloc = mine > 0u ? mine : 1u; nx = cnt > 0u ? cnt : 1u;
}
DI void xcd_barrier(const XcdBarrier& b) {
    asm volatile("s_waitcnt vmcnt(0)" ::: "memory");
    __syncthreads();
    if (threadIdx.x == 0) {
        unsigned* bar = b.bar;
        __builtin_amdgcn_s_waitcnt(0);
        unsigned nloc = b.st[0], nx = b.st[1];
        if (nloc == 0u) { xcd_barrier_complete(bar, b.x, nloc, nx); b.st[0] = nloc; b.st[1] = nx; }
        const unsigned old = xb_add(&bar[XB_XSUB(b.x)], 1u);
        const unsigned gen = old / nloc;
        if (old + 1u == (gen + 1u) * nloc) {
            __builtin_amdgcn_fence(__ATOMIC_RELEASE, "agent");
            asm volatile("s_waitcnt vmcnt(0)" ::: "memory");
            const unsigned og = xb_add(&bar[XB_TOP], 1u);
            const unsigned tg = og / nx;
            if (og + 1u == (tg + 1u) * nx) xb_add(&bar[XB_TOPGEN], 1u);
            else XB_SPIN(xb_ld(&bar[XB_TOPGEN]) == tg, bar);
            __builtin_amdgcn_fence(__ATOMIC_ACQUIRE, "agent");
            xb_add(&bar[XB_XGEN(b.x)], 1u);
            asm volatile("s_waitcnt vmcnt(0)" ::: "memory");
        } else {
            XB_SPIN(xb_ld(&bar[XB_XGEN(b.x)]) == gen, bar);
            __builtin_amdgcn_fence(__ATOMIC_ACQUIRE, "agent");
            asm volatile("s_waitcnt vmcnt(0)" ::: "memory");
        }
    }
    __syncthreads();
}

struct Args {
    const float* x; const float* mix_g; const float* w_in; const float* lq1; const float* lk1; const float* lq2; const float* lk2; const float* subg;
    const float* w_bsb; const float* w_bd; const float* w_out; const float* ffn_g; const float* w_gr; const float* w_er; const float* w_gate; const float* w_up; const float* w_down; const float* fin_g;
    float* out; unsigned char* ws;
};

DI void transpose_item(const float* W, int N, int k0, int n0, bf16_t* WT, int ldk, int drow0, int koff, LAS float* scr, int lane) {
#pragma unroll 8
    for (int i = 0; i < 32; ++i) { const int kk = 2 * i + (lane >> 5); scr[kk * 33 + (lane & 31)] = W[(size_t)(k0 + kk) * N + n0 + (lane & 31)]; }
    LDS_WAIT(); asm volatile("" ::: "memory");
    const int c = lane & 7;
#pragma unroll
    for (int j = 0; j < 4; ++j) { const int n = (lane >> 3) + 8 * j; const LAS float* s = scr + (8 * c) * 33 + n;
        u32x4 o; o.x = cvtpk(s[0 * 33], s[1 * 33]); o.y = cvtpk(s[2 * 33], s[3 * 33]); o.z = cvtpk(s[4 * 33], s[5 * 33]); o.w = cvtpk(s[6 * 33], s[7 * 33]);
        *(u32x4*)(WT + (size_t)(drow0 + n) * ldk + koff + k0 + 8 * c) = o; }
    LDS_WAIT(); asm volatile("" ::: "memory");
}
DI int winmap(int n0) { const int pn = n0 >> 8; if (pn < 12 || pn >= 20) return n0; const int lc = n0 & 255, s = lc >> 6, half = (lc >> 5) & 1; return (pn << 8) + 128 * half + 32 * s; }

DI void rms_row_bf16(const float* xrow, const float* g, bf16_t* orow, int lane) {
    const f32x4* xr = (const f32x4*)xrow + lane; f32x4 v[8]; float s = 0.f;
#pragma unroll
    for (int j = 0; j < 8; ++j) { v[j] = xr[64 * j]; s += (v[j][0] * v[j][0] + v[j][1] * v[j][1]) + (v[j][2] * v[j][2] + v[j][3] * v[j][3]); }
    const float rs = __builtin_amdgcn_rsqf(wave_sum(s) * (1.f / DM) + EPS);
    u32x2* o8 = (u32x2*)orow + lane;
#pragma unroll
    for (int j = 0; j < 8; ++j) { const f32x4 gg = ((const f32x4*)g)[lane + 64 * j]; u32x2 w; w.x = cvtpk(v[j][0] * rs * gg[0], v[j][1] * rs * gg[1]); w.y = cvtpk(v[j][2] * rs * gg[2], v[j][3] * rs * gg[3]); o8[64 * j] = w; }
}

constexpr int NWAVES = 8;
__global__ void __launch_bounds__(NWAVES * 64, 2) hybrid_fwd(Args args) {
    extern __shared__ __attribute__((aligned(16))) unsigned char lds_raw[];
    LAS unsigned char* lds = (LAS unsigned char*)lds_raw;
    const int tid = threadIdx.x, lane = tid & 63, wave = __builtin_amdgcn_readfirstlane(tid >> 6);
    const int G = gridDim.x, bx = blockIdx.x;
    const int vcu = (G % 8 == 0) ? (bx % 8) * (G / 8) + bx / 8 : bx;
#define KA_DECL const __attribute__((address_space(4))) Args* ka = (const __attribute__((address_space(4))) Args*)__builtin_amdgcn_kernarg_segment_ptr(); asm volatile("" : "+s"(ka)); \
    unsigned char* const ws = ka->ws; (void)ws
#define P_WINT ((bf16_t*)(ws + WS_WINT))
#define P_WBRT ((bf16_t*)(ws + WS_WBRT))
#define P_WOUTT ((bf16_t*)(ws + WS_WOUTT))
#define P_WGUT ((bf16_t*)(ws + WS_WGUT))
#define P_WDT ((bf16_t*)(ws + WS_WDT))
#define P_WRT ((bf16_t*)(ws + WS_WRT))
#define P_ROPE ((f32x2*)(ws + WS_ROPE))
#define P_SSQ ((float*)(ws + WS_SSQ))
#define P_TOKINFO ((int*)(ws + WS_TOKINFO))
#define P_TOKW ((float*)(ws + WS_TOKW))
#define P_TOKPOS ((int*)(ws + WS_TOKPOS))
#define P_ROWGATE ((float*)(ws + WS_ROWGATE))
#define P_BUFA ((bf16_t*)(ws + WS_A))
#define P_BUFB ((bf16_t*)(ws + WS_B))
#define P_HB ((bf16_t*)(ws + WS_H))
#define P_GSB ((bf16_t*)ka->out)
#define P_GDA ((bf16_t*)ka->out + (size_t)NTOK * 2048)
#define P_CNT ((unsigned*)(ws + WS_CTL) + CW_CNT)
    volatile LAS unsigned* MISC = (volatile LAS unsigned*)(lds + MISC_OFF);
    LAS int* tstart = (LAS int*)(lds + TST_OFF);
    for (int u = tid; u < (LDS_BYTES - LDSCTL_OFF) / 4; u += NWAVES * 64) ((LAS unsigned*)(lds + LDSCTL_OFF))[u] = 0u;
    __syncthreads();
    XcdBarrier bar;
    { KA_DECL; bar = xcd_barrier_post((unsigned*)(ws + WS_CTL) + CW_BAR, MISC + 8); }
    const int gw = vcu * NWAVES + wave, NGW = G * NWAVES;

#if DBG_STAGE != 1
    if (PH(0)) for (int rep_ = 0; rep_ < kReps[0]; ++rep_) { KA_DECL;
        LAS float* scr = (LAS float*)(lds + wave * 16384);
        constexpr int I_IN = 32 * 320, I_BR = 16 * 64, I_OUT = 32 * 64, I_G = 32 * 16, I_D = 8 * 64;
        constexpr int NITEMS = I_IN + 2 * I_BR + I_OUT + 32 * (2 * I_G + I_D);
        for (int it = gw; it < NITEMS; it += NGW) {
            int r = it;
            if (r < I_IN) { const int kb = r / 320, nb = r % 320; transpose_item(ka->w_in, INC, 64 * kb, 32 * nb, P_WINT, 2048, winmap(32 * nb), 0, scr, lane); continue; } r -= I_IN;
            if (r < I_BR) { const int kb = r / 64, nb = r % 64; transpose_item(ka->w_bsb, 2048, 64 * kb, 32 * nb, P_WBRT, 2048, 32 * nb, 0, scr, lane); continue; } r -= I_BR;
            if (r < I_BR) { const int kb = r / 64, nb = r % 64; transpose_item(ka->w_bd, 2048, 64 * kb, 32 * nb, P_WBRT, 2048, 32 * nb, 1024, scr, lane); continue; } r -= I_BR;
            if (r < I_OUT) { const int kb = r / 64, nb = r % 64; transpose_item(ka->w_out, 2048, 64 * kb, 32 * nb, P_WOUTT, 2048, 32 * nb, 0, scr, lane); continue; } r -= I_OUT;
            if (r < 32 * I_G) { const int e = r / I_G, q = r % I_G, kb = q / 16, nb = q % 16, n0 = 32 * nb;
                transpose_item(ka->w_gate + (size_t)e * 2048 * 512, 512, 64 * kb, n0, P_WGUT + (size_t)e * 1024 * 2048, 2048, 256 * (n0 >> 7) + (n0 & 127), 0, scr, lane); continue; } r -= 32 * I_G;
            if (r < 32 * I_G) { const int e = r / I_G, q = r % I_G, kb = q / 16, nb = q % 16, n0 = 32 * nb;
                transpose_item(ka->w_up + (size_t)e * 2048 * 512, 512, 64 * kb, n0, P_WGUT + (size_t)e * 1024 * 2048, 2048, 256 * (n0 >> 7) + 128 + (n0 & 127), 0, scr, lane); continue; } r -= 32 * I_G;
            { const int e = r / I_D, q = r % I_D, kb = q / 64, nb = q % 64;
                transpose_item(ka->w_down + (size_t)e * 512 * 2048, 2048, 64 * kb, 32 * nb, P_WDT + (size_t)e * 2048 * 512, 512, 32 * nb, 0, scr, lane); }
        }
        for (int idx = bx * 512 + tid; idx < SEQ * 32; idx += G * 512) {
            const int pos = idx >> 5, i = idx & 31;
            const float invf = __builtin_amdgcn_exp2f(-(float)i * (13.287712379549449f / 32.f));
            const float ang = (float)pos * invf;
            double rev = (double)ang * 0.15915494309189535; rev -= __builtin_floor(rev);
            const float rf = (float)rev;
            P_ROPE[idx] = (f32x2){__builtin_amdgcn_cosf(rf), __builtin_amdgcn_sinf(rf)};
        }
        for (int idx = bx * 512 + tid; idx < 64 * 2048; idx += G * 512) {
            const int j = idx >> 11, k = idx & 2047; float v = 0.f;
            if (j < 4) v = ka->w_gr[k * 4 + j] * ka->ffn_g[k]; else if (j < 36) v = ka->w_er[k * 32 + (j - 4)] * ka->ffn_g[k];
            P_WRT[idx] = (bf16_t)(cvtpk(v, 0.f) & 0xffffu);
        }
        for (int m = gw; m < NTOK; m += NGW) rms_row_bf16(ka->x + (size_t)m * DM, ka->mix_g, P_BUFA + (size_t)m * DM, lane);
        xcd_barrier(bar);
    }

    if (PH(1)) for (int rep_ = 0; rep_ < kReps[1]; ++rep_) { KA_DECL;
        pg8::Gemm g{P_BUFA, P_WINT, NTOK, INC, DM}; pg8::StaticOrder S; S.init(NTOK, INC, G, bx);
        pg8::EpiInProj E{P_BUFB, P_GSB, P_GDA, P_ROPE};
        pg8::gemm_phase<pg8::EpiInProj, pg8::StaticOrder, true, true>(lds, g, S, E);
        xcd_barrier(bar);
    }

    if (PH(2)) for (int rep_ = 0; rep_ < kReps[2]; ++rep_) { KA_DECL;
        const float a = ka->lq1[lane] * ka->lk1[lane], b2 = ka->lq2[lane] * ka->lk2[lane];
        const float lam = __expf(wave_sum(a)) - __expf(wave_sum(b2)) + 0.2f;
        const bf16_t* qsb = P_BUFB; const bf16_t* ksb = P_BUFB + (size_t)NTOK * 1024; const bf16_t* vsb = P_BUFB + (size_t)2 * NTOK * 1024;
        const bf16_t* qda = P_BUFB + (size_t)3 * NTOK * 1024; const bf16_t* kda = P_BUFB + (size_t)4 * NTOK * 1024; const bf16_t* vda = P_BUFB + (size_t)5 * NTOK * 1024;
        for (int u = vcu; u < 256; u += G) {
            const int bh = u >> 2, pi = u & 3, b = bh >> 3, hd = bh & 7;
#ifndef ATT_MASK
#define ATT_MASK 3
#endif
            if (ATT_MASK & 1) for (int k = 0; k < 2 * REP_SB; ++k) att::sb_unit(lds, qsb, ksb, vsb, P_BUFA, b, hd, (k & 1) == 0 ? 7 - pi : pi);
            if (ATT_MASK & 2) for (int k = 0; k < 4 * REP_DA; ++k) att::da_unit(lds, qda, kda, vda, P_BUFA, ka->subg, lam, b, hd, (k & 1) ? 2 * pi + ((k >> 1) & 1) : 15 - 2 * pi - ((k >> 1) & 1));
        }
        xcd_barrier(bar);
    }

    if (PH(3)) for (int rep_ = 0; rep_ < kReps[3]; ++rep_) { KA_DECL;
        pg8::Gemm g{P_BUFA, P_WBRT, NTOK, DM, DM}; pg8::StaticOrder S; S.init(NTOK, DM, G, bx);
        pg8::EpiMerged E{P_GSB, P_GDA, P_BUFB};
        pg8::gemm_phase<pg8::EpiMerged, pg8::StaticOrder, true, true>(lds, g, S, E);
        xcd_barrier(bar);
    }

    if (PH(4)) for (int rep_ = 0; rep_ < kReps[4]; ++rep_) { KA_DECL;
        pg8::Gemm g{P_BUFB, P_WOUTT, NTOK, DM, DM}; pg8::StaticOrder S; S.init(NTOK, DM, G, bx);
        pg8::EpiX1 E{ka->x, P_BUFA, P_SSQ};
        pg8::gemm_phase<pg8::EpiX1, pg8::StaticOrder, true, true>(lds, g, S, E);
        xcd_barrier(bar);
    }
#endif

#if DBG_STAGE == 0
    if (PH(5)) for (int rep_ = 0; rep_ < kReps[5]; ++rep_) { KA_DECL;
        LAS float* lg = (LAS float*)(lds + wave * 4096);
        const int fr = lane & 15, fq = lane >> 4;
        for (int tb = gw; tb < NTOK / 16; tb += NGW) {
            const int tok0 = tb * 16;
            f32x4 acc[3]; acc[0] = (f32x4){0.f, 0.f, 0.f, 0.f}; acc[1] = acc[0]; acc[2] = acc[0];
            const bf16_t* ap = P_BUFA + (size_t)(tok0 + fr) * DM + 8 * fq;
            const bf16_t* bp = P_WRT + (size_t)fr * DM + 8 * fq;
#pragma unroll 4
            for (int kk = 0; kk < DM / 32; ++kk) {
                const bf16x8 a = *(const bf16x8*)(ap + 32 * kk);
#pragma unroll
                for (int nt = 0; nt < 3; ++nt) { const bf16x8 bb = *(const bf16x8*)(bp + (size_t)16 * nt * DM + 32 * kk); acc[nt] = __builtin_amdgcn_mfma_f32_16x16x32_bf16(a, bb, acc[nt], 0, 0, 0); }
            }
            float rs[4];
#pragma unroll
            for (int rg = 0; rg < 4; ++rg) { const f32x4* sp = (const f32x4*)(P_SSQ + (size_t)(tok0 + 4 * fq + rg) * 32); float s = 0.f;
#pragma unroll
                for (int w = 0; w < 8; ++w) { const f32x4 v = sp[w]; s += (v[0] + v[1]) + (v[2] + v[3]); }
                rs[rg] = __builtin_amdgcn_rsqf(s * (1.f / DM) + EPS); }
#pragma unroll
            for (int nt = 0; nt < 3; ++nt)
#pragma unroll
                for (int rg = 0; rg < 4; ++rg) lg[(4 * fq + rg) * 64 + 16 * nt + fr] = acc[nt][rg] * rs[rg];
            LDS_WAIT(); asm volatile("" ::: "memory");
            if (lane < 16) {
                const LAS float* L = lg + lane * 64;
                float g0 = L[0]; int grp = 0;
#pragma unroll
                for (int j = 1; j < 4; ++j) { const float v = L[j]; if (v > g0) { g0 = v; grp = j; } }
                float den = 0.f;
#pragma unroll
                for (int j = 0; j < 4; ++j) den += __expf(L[j] - g0);
                const float pg = 1.f / den;
                const LAS float* E = L + 4 + 8 * grp;
                float v0 = E[0]; int i0 = 0;
#pragma unroll
                for (int j = 1; j < 8; ++j) { const float v = E[j]; if (v > v0) { v0 = v; i0 = j; } }
                float v1 = -3.0e38f; int i1 = 0;
#pragma unroll
                for (int j = 0; j < 8; ++j) { const float v = E[j]; if (j != i0 && v > v1) { v1 = v; i1 = j; } }
                const float e1 = __expf(v1 - v0), w0 = pg / (1.f + e1), w1 = pg * e1 / (1.f + e1);
                const int ex0 = grp * 8 + i0, ex1 = grp * 8 + i1;
                const int rk0 = (int)atomicAdd(P_CNT + ex0, 1u), rk1 = (int)atomicAdd(P_CNT + ex1, 1u);
                const int t = tok0 + lane;
                *(int4*)(P_TOKINFO + 4 * (size_t)t) = make_int4(ex0, rk0, ex1, rk1);
                *(float2*)(P_TOKW + 2 * (size_t)t) = make_float2(w0, w1);
            }
            LDS_WAIT(); asm volatile("" ::: "memory");
        }
        xcd_barrier(bar);
    }

    if (PH(6)) for (int rep_ = 0; rep_ < kReps[6]; ++rep_) { KA_DECL;
        if (tid == 0) { int accu = 0; for (int e = 0; e < 32; ++e) { tstart[e] = accu; accu += ((int)__hip_atomic_load(P_CNT + e, RLX_AGENT) + 255) >> 8; } tstart[32] = accu; }
        __syncthreads();
        for (int t = gw; t < NTOK; t += NGW) {
            const int4 ti = *(const int4*)(P_TOKINFO + 4 * (size_t)t); const float2 tw = *(const float2*)(P_TOKW + 2 * (size_t)t);
            const int pos0 = 256 * tstart[ti.x] + ti.y, pos1 = 256 * tstart[ti.z] + ti.w;
            float s = (lane < 32) ? P_SSQ[(size_t)t * 32 + lane] : 0.f; s = wave_sum(s);
            const float rs = __builtin_amdgcn_rsqf(s * (1.f / DM) + EPS);
            const u32x4* src = (const u32x4*)(P_BUFA + (size_t)t * DM);
#pragma unroll
            for (int j = 0; j < 4; ++j) { const int c16 = lane + 64 * j; const u32x4 v = src[c16];
                const f32x4 g0 = ((const f32x4*)ka->ffn_g)[2 * c16], g1 = ((const f32x4*)ka->ffn_g)[2 * c16 + 1];
                u32x4 o; o.x = cvtpk(bflo(v.x) * rs * g0[0], bfhi(v.x) * rs * g0[1]); o.y = cvtpk(bflo(v.y) * rs * g0[2], bfhi(v.y) * rs * g0[3]);
                o.z = cvtpk(bflo(v.z) * rs * g1[0], bfhi(v.z) * rs * g1[1]); o.w = cvtpk(bflo(v.w) * rs * g1[2], bfhi(v.w) * rs * g1[3]);
                ((u32x4*)(P_BUFB + (size_t)pos0 * DM))[c16] = o; ((u32x4*)(P_BUFB + (size_t)pos1 * DM))[c16] = o; }
            if (lane == 0) { P_ROWGATE[pos0] = tw.x; P_ROWGATE[pos1] = tw.y; *(int2*)(P_TOKPOS + 2 * (size_t)t) = make_int2(pos0, pos1); }
        }
        xcd_barrier(bar);
    }

    if (PH(7)) for (int rep_ = 0; rep_ < kReps[7]; ++rep_) { KA_DECL;
        pg8::Gemm g{P_BUFB, P_WGUT, PROWS, 1024, DM}; pg8::MoeOrder S{tstart, 4, G, bx};
        pg8::EpiSwiglu E{P_HB};
        pg8::gemm_phase<pg8::EpiSwiglu, pg8::MoeOrder, true, true>(lds, g, S, E);
        xcd_barrier(bar);
    }

    if (PH(8)) for (int rep_ = 0; rep_ < kReps[8]; ++rep_) { KA_DECL;
        pg8::Gemm g{P_HB, P_WDT, PROWS, 2048, DE}; pg8::MoeOrder S{tstart, 8, G, bx};
        pg8::EpiDown E{P_ROWGATE, P_BUFB};
        pg8::gemm_phase<pg8::EpiDown, pg8::MoeOrder, true, true>(lds, g, S, E);
        xcd_barrier(bar);
    }
#endif

    if (PH(9)) for (int rep_ = 0; rep_ < kReps[9]; ++rep_) { KA_DECL;
    for (int t = gw; t < NTOK; t += NGW) {
        f32x4 v[8];
#if DBG_STAGE == 1
        { const f32x4* xr = (const f32x4*)(ka->x + (size_t)t * DM) + lane;
#pragma unroll
          for (int j = 0; j < 8; ++j) v[j] = xr[64 * j]; }
#else
        { const u32x2* xr = (const u32x2*)(P_BUFA + (size_t)t * DM) + lane;
#if DBG_STAGE == 0
          const int2 tp = *(const int2*)(P_TOKPOS + 2 * (size_t)t);
          const u32x2* ya = (const u32x2*)(P_BUFB + (size_t)tp.x * DM) + lane; const u32x2* yb = (const u32x2*)(P_BUFB + (size_t)tp.y * DM) + lane;
#endif
#pragma unroll
          for (int j = 0; j < 8; ++j) { const u32x2 w = xr[64 * j]; v[j] = (f32x4){bflo(w.x), bfhi(w.x), bflo(w.y), bfhi(w.y)};
#if DBG_STAGE == 0
              const u32x2 a = ya[64 * j], b = yb[64 * j];
              v[j] += (f32x4){bflo(a.x), bfhi(a.x), bflo(a.y), bfhi(a.y)}; v[j] += (f32x4){bflo(b.x), bfhi(b.x), bflo(b.y), bfhi(b.y)};
#endif
          } }
#endif
        float s = 0.f;
#pragma unroll
        for (int j = 0; j < 8; ++j) s += (v[j][0] * v[j][0] + v[j][1] * v[j][1]) + (v[j][2] * v[j][2] + v[j][3] * v[j][3]);
        const float rs = __builtin_amdgcn_rsqf(wave_sum(s) * (1.f / DM) + EPS);
        f32x4* orow = (f32x4*)(ka->out + (size_t)t * DM) + lane;
#pragma unroll
        for (int j = 0; j < 8; ++j) { const f32x4 gg = ((const f32x4*)ka->fin_g)[lane + 64 * j]; orow[64 * j] = v[j] * rs * gg; }
    }
}
}

extern "C" void kernel_launch(void* const* d_in, const int* in_sizes, int n_in, void* d_out, int out_size, void* d_ws, size_t ws_size, hipStream_t stream) {
    static int grid = 0;
    if (grid == 0) {
        if (n_in != 18 || in_sizes[0] != NTOK * DM || out_size != NTOK * DM || ws_size < WS_END) {
            fprintf(stderr, "kernel_launch: unexpected shapes (n_in %d, in0 %d, out %d, ws %zu)\n", n_in, n_in > 0 ? in_sizes[0] : -1, out_size, ws_size); grid = -1; return; }
        int dev = 0, cus = 0;
        if (hipGetDevice(&dev) != hipSuccess || hipDeviceGetAttribute(&cus, hipDeviceAttributeMultiprocessorCount, dev) != hipSuccess) { grid = -1; return; }
        if (hipFuncSetAttribute((const void*)hybrid_fwd, hipFuncAttributeMaxDynamicSharedMemorySize, LDS_BYTES) != hipSuccess) { fprintf(stderr, "kernel_launch: hipFuncSetAttribute failed\n"); grid = -1; return; }
        int per_cu = 0;
        if (hipOccupancyMaxActiveBlocksPerMultiprocessor(&per_cu, (const void*)hybrid_fwd, NWAVES * 64, LDS_BYTES) != hipSuccess || per_cu < 1) { fprintf(stderr, "kernel_launch: occupancy query says %d\n", per_cu); }
        (void)hipGetLastError();
        grid = cus;
    }
    if (grid < 0) return;
    if (hipMemsetAsync((char*)d_ws + WS_CTL, 0, CTL_ZERO_BYTES, stream) != hipSuccess) return;
    Args a{};
    a.x = (const float*)d_in[0]; a.mix_g = (const float*)d_in[1]; a.w_in = (const float*)d_in[2]; a.lq1 = (const float*)d_in[3]; a.lk1 = (const float*)d_in[4];
    a.lq2 = (const float*)d_in[5]; a.lk2 = (const float*)d_in[6]; a.subg = (const float*)d_in[7]; a.w_bsb = (const float*)d_in[8]; a.w_bd = (const float*)d_in[9];
    a.w_out = (const float*)d_in[10]; a.ffn_g = (const float*)d_in[11]; a.w_gr = (const float*)d_in[12]; a.w_er = (const float*)d_in[13]; a.w_gate = (const float*)d_in[14];
    a.w_up = (const float*)d_in[15]; a.w_down = (const float*)d_in[16]; a.fin_g = (const float*)d_in[17];
    a.out = (float*)d_out; a.ws = (unsigned char*)d_ws;
    hipLaunchKernelGGL(hybrid_fwd, dim3(grid), dim3(NWAVES * 64), LDS_BYTES, stream, a);
}
```

```cpp
#include <hip/hip_runtime.h>
#include <cstdio>
#include <cstdint>

#ifndef DBG_STAGE
#define DBG_STAGE 0
#endif

#ifndef PH_MASK
#define PH_MASK 0x3ff
#endif
#define PH(k) ((PH_MASK >> (k)) & 1)
#ifndef REP_LIST
#define REP_LIST 1, 1, 1, 1, 1, 1, 1, 1, 1, 1
#endif
#ifndef REP_SB
#define REP_SB 1
#endif
#ifndef REP_DA
#define REP_DA 1
#endif
constexpr int kReps[10] = {REP_LIST};
#define DI __device__ __forceinline__
#define LAS __attribute__((address_space(3)))
#define GAS __attribute__((address_space(1)))
typedef unsigned short bf16_t;
typedef short bf16x8 __attribute__((ext_vector_type(8)));
typedef short s16x4 __attribute__((ext_vector_type(4)));
typedef float f32x2 __attribute__((ext_vector_type(2)));
typedef float f32x4 __attribute__((ext_vector_type(4)));
typedef float f32x16 __attribute__((ext_vector_type(16)));
typedef unsigned u32x2 __attribute__((ext_vector_type(2)));
typedef unsigned u32x4 __attribute__((ext_vector_type(4)));
typedef int v8i32 __attribute__((ext_vector_type(8)));
typedef int i32x4 __attribute__((ext_vector_type(4)));
typedef __bf16 bf16x2_t __attribute__((ext_vector_type(2)));

constexpr int DM = 2048, NTOK = 16384, SEQ = 2048, INC = 10240, NEXP = 32, DE = 512;
constexpr int PROWS = 40960;
constexpr float EPS = 1e-6f;
constexpr float LOG2E = 1.4426950408889634f;
constexpr float C_SB = LOG2E * 0.08838834764831845f;
constexpr float C_DA = LOG2E * 0.125f;

DI unsigned cvtpk(float lo, float hi) { f32x2 v = {lo, hi}; bf16x2_t b = __builtin_convertvector(v, bf16x2_t); return __builtin_bit_cast(unsigned, b); }
DI unsigned pk4_fp8(float a, float b, float c, float d) { int w = 0; w = __builtin_amdgcn_cvt_pk_fp8_f32(a, b, w, false); w = __builtin_amdgcn_cvt_pk_fp8_f32(c, d, w, true); return (unsigned)w; }
DI float sat8(float v) { return __builtin_amdgcn_fmed3f(v, -448.f, 448.f); }
DI unsigned pk4_fp8_sat(float a, float b, float c, float d) { return pk4_fp8(sat8(a), sat8(b), sat8(c), sat8(d)); }
DI float bf2f(unsigned short b) { return __builtin_bit_cast(float, (unsigned)b << 16); }
DI float bflo(unsigned w) { return __builtin_bit_cast(float, w << 16); }
DI float bfhi(unsigned w) { return __builtin_bit_cast(float, w & 0xffff0000u); }
DI float fexp2(float x) { return __builtin_amdgcn_exp2f(x); }
DI float flog2(float x) { return __builtin_amdgcn_logf(x); }
DI float frcp(float x) { return __builtin_amdgcn_rcpf(x); }
template <int X> DI float swzx(float v) { return __uint_as_float((unsigned)__builtin_amdgcn_ds_swizzle((int)__float_as_uint(v), (X << 10) | 0x1F)); }
DI float half_swap_sum(float v) { auto rr = __builtin_amdgcn_permlane32_swap(__float_as_uint(v), __float_as_uint(v), false, false); return __uint_as_float(rr[0]) + __uint_as_float(rr[1]); }
DI float wave_sum(float v) { v += swzx<1>(v); v += swzx<2>(v); v += swzx<4>(v); v += swzx<8>(v); v += swzx<16>(v); return half_swap_sum(v); }

namespace pg8 {
constexpr int BM = 256, BK = 64, HALF = 128, HTB = HALF * BK * 2, STAGE_BYTES = 8 * HTB, NXCD = 8, WGM = 8;
__host__ __device__ __forceinline__ int lds_byte(int r, int c) { const int c8 = c >> 3; return (r >> 3) * 1024 + (r & 7) * 128 + ((c8 ^ (r & 7)) << 4) + (c & 7) * 2; }
__host__ __device__ __forceinline__ void stage_rc(int b, int& R, int& C) { const int blk = b >> 10, w = (b & 1023) >> 4, r8 = w >> 3, c8 = (w & 7) ^ r8; R = blk * 8 + r8; C = c8 * 8 + (b & 15) / 2; }
__host__ __device__ __forceinline__ int perm32(int rho) { const int n = rho >> 4, i = rho & 15; return 8 * (i >> 2) + 4 * n + (i & 3); }

struct Unit { int pm, pn, bt; };
struct Gemm { const bf16_t* A; const bf16_t* Bt; int M, N, K; };

struct StaticOrder {
    int nM, nN, nwg, G, c;
    __host__ __device__ void init(int M, int N, int G_, int c_) { nM = M / BM; nN = N / BM; nwg = nM * nN; G = G_; c = c_; }
    __host__ __device__ bool next(int i, Unit& u) const {
        const long L = (long)i * G + c; if (L >= nwg) return false;
        int wgid = (int)L; { const int q = nwg / NXCD, r = nwg % NXCD, xcd = wgid % NXCD, off = wgid / NXCD; wgid = (xcd < r ? xcd * (q + 1) : r * (q + 1) + (xcd - r) * q) + off; }
        const int nig = WGM * nN, gid = wgid / nig, fm = gid * WGM, gsz = (nM - fm) < WGM ? (nM - fm) : WGM;
        u.pm = fm + ((wgid % nig) % gsz); u.pn = (wgid % nig) / gsz; u.bt = u.pn; return true;
    }
};
struct MoeOrder {
    const LAS int* tstart; int npn, G, c;
    DI bool next(int i, Unit& u) const {
        const int T = tstart[32], x = c & 7, lo = (T * x) >> 3, hi = (T * (x + 1)) >> 3;
        const int j = i * (G >> 3) + (c >> 3);
        const bool ok = j < (hi - lo) * npn;
        int tile = ok ? lo + j / npn : 0, pn = ok ? j % npn : 0, e = 0;
#pragma unroll
        for (int k = 1; k < 32; ++k) e += (tstart[k] <= tile) ? 1 : 0;
        u.pm = __builtin_amdgcn_readfirstlane(tile); u.pn = __builtin_amdgcn_readfirstlane(pn); u.bt = __builtin_amdgcn_readfirstlane(e * npn + pn);
        return __builtin_amdgcn_readfirstlane((int)ok) != 0;
    }
};

template <class Epi, class Sched, bool ALIGN_EPI, bool SP2>
DI void gemm_phase(LAS unsigned char* lds, const Gemm g, const Sched& S, const Epi& E) {
    int tid = threadIdx.x; asm volatile("" : "+v"(tid));
    const int wid = __builtin_amdgcn_readfirstlane(tid >> 6), lane = tid & 63, wr = wid >> 2, wc = wid & 3, fr = lane & 15, fq = lane >> 4;
    const int K = g.K, nt = K / BK;
    unsigned voffA[2], voffB[2];
#pragma unroll
    for (int i = 0; i < 2; ++i) { int R, C; stage_rc(tid * 16 + i * 8192, R, C); const int Rb = Epi::PERM ? ((R & ~31) + perm32(R & 31)) : R;
        voffA[i] = (unsigned)(R * K + C) * 2u; voffB[i] = (unsigned)(Rb * K + C) * 2u; }
    const size_t kstep = (size_t)(BK * 2);
    const size_t hstep = (size_t)HALF * K * 2;
    const size_t tstep = 2 * hstep;
    const unsigned ldsw = (unsigned)wid * 1024u;
    const int aoff = lds_byte(wr * 64 + fr, fq * 8), boff = lds_byte(wc * 32 + fr, fq * 8), aoff1 = aoff ^ 64, boff1 = boff ^ 64;
#define PG8_SA(b, h) (((b) * 2 + (h)) * HTB)
#define PG8_SB(b, h) ((4 + (b) * 2 + (h)) * HTB)
#define PG8_STAGE(bufoff, gbase, voff) do { _Pragma("unroll") for (int _i = 0; _i < 2; ++_i) \
        __builtin_amdgcn_global_load_lds((const unsigned*)((const char*)(gbase) + (voff)[_i]), (LAS unsigned*)(lds + (bufoff) + ldsw + _i * 8192), 16, 0, 0); } while (0)
#define PG8_LDA(dst, b, h) do { _Pragma("unroll") for (int m = 0; m < 4; ++m) _Pragma("unroll") for (int k = 0; k < 2; ++k) dst[m][k] = *(const LAS bf16x8*)(lds + PG8_SA(b, h) + (k ? aoff1 : aoff) + m * 2048); } while (0)
#define PG8_LDB(dst, b, h) do { _Pragma("unroll") for (int n = 0; n < 2; ++n) _Pragma("unroll") for (int k = 0; k < 2; ++k) dst[n][k] = *(const LAS bf16x8*)(lds + PG8_SB(b, h) + (k ? boff1 : boff) + n * 2048); } while (0)
#define PG8_MMA(ai, bj, At, Bt) do { __builtin_amdgcn_s_setprio(1); _Pragma("unroll") for (int m = 0; m < 4; ++m) _Pragma("unroll") for (int n = 0; n < 2; ++n) _Pragma("unroll") for (int k = 0; k < 2; ++k) \
        acc[ai][bj][m][n] = __builtin_amdgcn_mfma_f32_16x16x32_bf16(Bt[n][k], At[m][k], acc[ai][bj][m][n], 0, 0, 0); __builtin_amdgcn_s_setprio(0); } while (0)
#define PG8_WAIT_V(n) asm volatile("s_waitcnt vmcnt(" #n ")" ::: "memory")
#define PG8_WAIT_L(n) asm volatile("s_waitcnt lgkmcnt(" #n ")" ::: "memory")
#define PG8_BAR __builtin_amdgcn_s_barrier()
#define PG8_SCHED __builtin_amdgcn_sched_barrier(0)
    Unit cur, nxt; int ui = 0;
    if (!S.next(0, cur)) return;
    f32x4 acc[2][2][4][2];
#pragma unroll
    for (int a = 0; a < 2; ++a)
#pragma unroll
        for (int b = 0; b < 2; ++b)
#pragma unroll
            for (int m = 0; m < 4; ++m)
#pragma unroll
                for (int n = 0; n < 2; ++n) acc[a][b][m][n] = (f32x4){0.f, 0.f, 0.f, 0.f};
    bf16x8 At[4][2], B0[2][2], B1[2][2];
    const char* cA = (const char*)g.A + (size_t)cur.pm * tstep; const char* cB = (const char*)g.Bt + (size_t)cur.bt * tstep;
    if constexpr (SP2) {
        PG8_STAGE(PG8_SB(0, 0), cB, voffB); PG8_STAGE(PG8_SB(0, 1), cB + hstep, voffB); PG8_STAGE(PG8_SA(0, 0), cA, voffA); PG8_STAGE(PG8_SA(0, 1), cA + hstep, voffA);
        if (wr == 1) PG8_BAR;
        PG8_WAIT_V(2); PG8_BAR;
        PG8_STAGE(PG8_SB(1, 0), cB + kstep, voffB); PG8_STAGE(PG8_SA(1, 0), cA + kstep, voffA); PG8_STAGE(PG8_SB(1, 1), cB + hstep + kstep, voffB);
        PG8_WAIT_V(6); PG8_BAR;
    } else {
        PG8_STAGE(PG8_SB(0, 0), cB, voffB); PG8_STAGE(PG8_SA(0, 0), cA, voffA); PG8_STAGE(PG8_SB(0, 1), cB + hstep, voffB); PG8_STAGE(PG8_SA(0, 1), cA + hstep, voffA);
        if (wr == 1) PG8_BAR;
        PG8_WAIT_V(4); PG8_BAR;
        PG8_STAGE(PG8_SB(1, 0), cB + kstep, voffB); PG8_STAGE(PG8_SA(1, 0), cA + kstep, voffA); PG8_STAGE(PG8_SB(1, 1), cB + hstep + kstep, voffB);
        PG8_WAIT_V(6); PG8_BAR;
    }
    for (;;) {
        const bool has_next = S.next(ui + 1, nxt);
        const char* nA = has_next ? (const char*)g.A + (size_t)nxt.pm * tstep : cA; const char* nB = has_next ? (const char*)g.Bt + (size_t)nxt.bt * tstep : cB;
        for (int t = 0; t < nt; t += 2) {
            const bool last = (t == nt - 2);
            const char* a1 = cA + (size_t)(t + 1) * kstep;
            const char* a2 = last ? nA : cA + (size_t)(t + 2) * kstep; const char* b2 = last ? nB : cB + (size_t)(t + 2) * kstep;
            const char* a3 = a2 + kstep; const char* b3 = b2 + kstep;
            if constexpr (Epi::HAS_MID) { if (t == Epi::MID_T) E.mid(acc, cur, wr, wc, fr, fq); }
            if constexpr (SP2) {
            PG8_LDB(B0, 0, 0); PG8_LDB(B1, 0, 1); PG8_SCHED; PG8_LDA(At, 0, 0); PG8_STAGE(PG8_SA(1, 1), a1 + hstep, voffA);
            PG8_WAIT_V(8); PG8_WAIT_L(0); PG8_BAR; PG8_MMA(0, 0, At, B0); PG8_MMA(0, 1, At, B1); PG8_BAR; PG8_SCHED;
            PG8_LDA(At, 0, 1); PG8_STAGE(PG8_SB(0, 0), b2, voffB); PG8_STAGE(PG8_SB(0, 1), b2 + hstep, voffB); PG8_STAGE(PG8_SA(0, 0), a2, voffA);
            PG8_WAIT_V(8); PG8_WAIT_L(0); PG8_BAR; PG8_MMA(1, 0, At, B0); PG8_MMA(1, 1, At, B1); PG8_BAR; PG8_SCHED;
            PG8_LDB(B0, 1, 0); PG8_LDB(B1, 1, 1); PG8_SCHED; PG8_LDA(At, 1, 0); PG8_STAGE(PG8_SA(0, 1), a2 + hstep, voffA);
            PG8_WAIT_V(8); PG8_WAIT_L(0); PG8_BAR; PG8_MMA(0, 0, At, B0); PG8_MMA(0, 1, At, B1); PG8_BAR; PG8_SCHED;
            PG8_LDA(At, 1, 1); PG8_STAGE(PG8_SB(1, 0), b3, voffB); PG8_STAGE(PG8_SB(1, 1), b3 + hstep, voffB); PG8_STAGE(PG8_SA(1, 0), a3, voffA);
            PG8_WAIT_V(8); PG8_WAIT_L(0); PG8_BAR; PG8_MMA(1, 0, At, B0); PG8_MMA(1, 1, At, B1); PG8_BAR; PG8_SCHED;
            } else {
            PG8_LDB(B0, 0, 0); PG8_SCHED; PG8_LDA(At, 0, 0); PG8_STAGE(PG8_SA(1, 1), a1 + hstep, voffA);
            PG8_WAIT_L(8); PG8_BAR; PG8_WAIT_L(0); PG8_MMA(0, 0, At, B0); PG8_BAR; PG8_SCHED;
            PG8_LDB(B1, 0, 1); PG8_STAGE(PG8_SB(0, 0), b2, voffB);
            PG8_BAR; PG8_WAIT_L(0); PG8_MMA(0, 1, At, B1); PG8_BAR;
            PG8_LDA(At, 0, 1); PG8_STAGE(PG8_SA(0, 0), a2, voffA);
            PG8_BAR; PG8_WAIT_L(0); PG8_MMA(1, 0, At, B0); PG8_BAR; PG8_SCHED;
            PG8_STAGE(PG8_SB(0, 1), b2 + hstep, voffB);
            PG8_WAIT_V(6); PG8_BAR; PG8_MMA(1, 1, At, B1); PG8_BAR;
            PG8_LDB(B0, 1, 0); PG8_SCHED; PG8_LDA(At, 1, 0); PG8_STAGE(PG8_SA(0, 1), a2 + hstep, voffA);
            PG8_WAIT_L(8); PG8_BAR; PG8_WAIT_L(0); PG8_MMA(0, 0, At, B0); PG8_BAR; PG8_SCHED;
            PG8_LDB(B1, 1, 1); PG8_STAGE(PG8_SB(1, 0), b3, voffB);
            PG8_BAR; PG8_WAIT_L(0); PG8_MMA(0, 1, At, B1); PG8_BAR;
            PG8_LDA(At, 1, 1); PG8_STAGE(PG8_SA(1, 0), a3, voffA);
            PG8_BAR; PG8_WAIT_L(0); PG8_MMA(1, 0, At, B0); PG8_BAR; PG8_SCHED;
            PG8_STAGE(PG8_SB(1, 1), b3 + hstep, voffB);
            PG8_WAIT_V(6); PG8_BAR; PG8_MMA(1, 1, At, B1); PG8_BAR;
            }
        }
        if constexpr (ALIGN_EPI) { if (wr == 0) PG8_BAR; }
        E(acc, cur, wr, wc, fr, fq);
        if (!has_next) break;
#pragma unroll
        for (int a = 0; a < 2; ++a)
#pragma unroll
            for (int b = 0; b < 2; ++b)
#pragma unroll
                for (int m = 0; m < 4; ++m)
#pragma unroll
                    for (int n = 0; n < 2; ++n) acc[a][b][m][n] = (f32x4){0.f, 0.f, 0.f, 0.f};
        cur = nxt; cA = nA; cB = nB; ++ui;
        if constexpr (ALIGN_EPI) { if (wr == 1) PG8_BAR; }
    }
    PG8_WAIT_V(0);
    if constexpr (!ALIGN_EPI) { if (wr == 0) PG8_BAR; }
    PG8_BAR;
#undef PG8_SA
#undef PG8_SB
#undef PG8_STAGE
#undef PG8_LDA
#undef PG8_LDB
#undef PG8_MMA
#undef PG8_WAIT_V
#undef PG8_WAIT_L
#undef PG8_BAR
#undef PG8_SCHED
}

typedef f32x4 AccN[2][4][2];
template <class Epi, class Sched, int SCW, int SCX>
DI void gemm_f8_phase(LAS unsigned char* lds, const Gemm g, const Sched& S, const Epi& E) {
    int tid = threadIdx.x; asm volatile("" : "+v"(tid));
    const int wid = __builtin_amdgcn_readfirstlane(tid >> 6), lane = tid & 63, wr = wid >> 2, wc = wid & 3, fr = lane & 15, fq = lane >> 4;
    const int K = g.K, nt = K / BK;
    unsigned voffA[2], voffB[2];
#pragma unroll
    for (int i = 0; i < 2; ++i) { int R, C; stage_rc(tid * 16 + i * 8192, R, C); const int Rb = (R & ~31) + perm32(R & 31);
        voffA[i] = (unsigned)(R * K + C) * 2u; voffB[i] = (unsigned)(Rb * K + C) * 2u; }
    const size_t kstep = (size_t)(BK * 2);
    const size_t hstep = (size_t)HALF * K * 2;
    const size_t tstep = 2 * hstep;
    const unsigned ldsw = (unsigned)wid * 1024u;
    const int aoff = lds_byte(wr * 64 + fr, fq * 8), boff = lds_byte(wc * 32 + fr, fq * 8), aoff1 = aoff ^ 64, boff1 = boff ^ 64;
    const int scw = SCW * 0x01010101, scx = SCX * 0x01010101;
#define PG8_SA(b, h) (((b) * 2 + (h)) * HTB)
#define PG8_SB(b, h) ((4 + (b) * 2 + (h)) * HTB)
#define PG8_STAGE(bufoff, gbase, voff) do { _Pragma("unroll") for (int _i = 0; _i < 2; ++_i) \
        __builtin_amdgcn_global_load_lds((const unsigned*)((const char*)(gbase) + (voff)[_i]), (LAS unsigned*)(lds + (bufoff) + ldsw + _i * 8192), 16, 0, 0); } while (0)
#define PG8_LD16(off) (*(const LAS i32x4*)(lds + (off)))
#define PG8_LDA8(dst, b, h) do { _Pragma("unroll") for (int m = 0; m < 4; ++m) dst[m] = __builtin_shufflevector(PG8_LD16(PG8_SA(b, h) + aoff + m * 2048), PG8_LD16(PG8_SA(b, h) + aoff1 + m * 2048), 0, 1, 2, 3, 4, 5, 6, 7); } while (0)
#define PG8_LDB8(dst, b) do { _Pragma("unroll") for (int n = 0; n < 2; ++n) dst[n] = __builtin_shufflevector(PG8_LD16(PG8_SB(b, 0) + boff + n * 2048), PG8_LD16(PG8_SB(b, 0) + boff1 + n * 2048), 0, 1, 2, 3, 4, 5, 6, 7); } while (0)
#define PG8_MMA8(ai) do { __builtin_amdgcn_s_setprio(1); _Pragma("unroll") for (int m = 0; m < 4; ++m) _Pragma("unroll") for (int n = 0; n < 2; ++n) \
        acc[ai][m][n] = __builtin_amdgcn_mfma_scale_f32_16x16x128_f8f6f4(B08[n], At8[m], acc[ai][m][n], 0, 0, 0, scw, 0, scx); __builtin_amdgcn_s_setprio(0); } while (0)
#define PG8_WAIT_V(n) asm volatile("s_waitcnt vmcnt(" #n ")" ::: "memory")
#define PG8_WAIT_L(n) asm volatile("s_waitcnt lgkmcnt(" #n ")" ::: "memory")
#define PG8_BAR __builtin_amdgcn_s_barrier()
#define PG8_SCHED __builtin_amdgcn_sched_barrier(0)
    Unit cur, nxt; int ui = 0;
    if (!S.next(0, cur)) return;
    f32x4 acc[2][4][2];
#pragma unroll
    for (int a = 0; a < 2; ++a)
#pragma unroll
        for (int m = 0; m < 4; ++m)
#pragma unroll
            for (int n = 0; n < 2; ++n) acc[a][m][n] = (f32x4){0.f, 0.f, 0.f, 0.f};
    v8i32 At8[4], B08[2];
    const char* cA = (const char*)g.A + (size_t)cur.pm * tstep; const char* cB = (const char*)g.Bt + (size_t)cur.bt * hstep;
    PG8_STAGE(PG8_SB(0, 0), cB, voffB); PG8_STAGE(PG8_SA(0, 0), cA, voffA); PG8_STAGE(PG8_SA(0, 1), cA + hstep, voffA);
    if (wr == 1) PG8_BAR;
    PG8_WAIT_V(2); PG8_BAR;
    PG8_STAGE(PG8_SB(1, 0), cB + kstep, voffB); PG8_STAGE(PG8_SA(1, 0), cA + kstep, voffA);
    PG8_WAIT_V(4); PG8_BAR;
    for (;;) {
        const bool has_next = S.next(ui + 1, nxt);
        const char* nA = has_next ? (const char*)g.A + (size_t)nxt.pm * tstep : cA; const char* nB = has_next ? (const char*)g.Bt + (size_t)nxt.bt * hstep : cB;
#pragma unroll 1
        for (int t = 0; t < nt; t += 2) {
            const bool last = (t == nt - 2);
            const char* a1 = cA + (size_t)(t + 1) * kstep;
            const char* a2 = last ? nA : cA + (size_t)(t + 2) * kstep; const char* b2 = last ? nB : cB + (size_t)(t + 2) * kstep;
            const char* a3 = a2 + kstep; const char* b3 = b2 + kstep;
            PG8_LDB8(B08, 0); PG8_SCHED; PG8_LDA8(At8, 0, 0); PG8_STAGE(PG8_SA(1, 1), a1 + hstep, voffA);
            PG8_WAIT_V(6); PG8_WAIT_L(0); PG8_BAR; PG8_MMA8(0); PG8_BAR; PG8_SCHED;
            PG8_LDA8(At8, 0, 1); PG8_STAGE(PG8_SB(0, 0), b2, voffB); PG8_STAGE(PG8_SA(0, 0), a2, voffA);
            PG8_WAIT_V(6); PG8_WAIT_L(0); PG8_BAR; PG8_MMA8(1); PG8_BAR; PG8_SCHED;
            PG8_LDB8(B08, 1); PG8_SCHED; PG8_LDA8(At8, 1, 0); PG8_STAGE(PG8_SA(0, 1), a2 + hstep, voffA);
            PG8_WAIT_V(6); PG8_WAIT_L(0); PG8_BAR; PG8_MMA8(0); PG8_BAR; PG8_SCHED;
            PG8_LDA8(At8, 1, 1); PG8_STAGE(PG8_SB(1, 0), b3, voffB); PG8_STAGE(PG8_SA(1, 0), a3, voffA);
            PG8_WAIT_V(6); PG8_WAIT_L(0); PG8_BAR; PG8_MMA8(1); PG8_BAR; PG8_SCHED;
        }
        if (wr == 0) PG8_BAR;
        E(acc, cur, wr, wc, fr, fq);
        if (!has_next) break;
#pragma unroll
        for (int a = 0; a < 2; ++a)
#pragma unroll
            for (int m = 0; m < 4; ++m)
#pragma unroll
                for (int n = 0; n < 2; ++n) acc[a][m][n] = (f32x4){0.f, 0.f, 0.f, 0.f};
        cur = nxt; cA = nA; cB = nB; ++ui;
        if (wr == 1) PG8_BAR;
    }
    PG8_WAIT_V(0);
    PG8_BAR;
#undef PG8_SA
#undef PG8_SB
#undef PG8_STAGE
#undef PG8_LD16
#undef PG8_LDA8
#undef PG8_LDB8
#undef PG8_MMA8
#undef PG8_WAIT_V
#undef PG8_WAIT_L
#undef PG8_BAR
#undef PG8_SCHED
}

typedef f32x4 AccQ[4][4];
template <class Epi, class Sched, int SCW, int SCX, int FMT = 0  >
DI void gemm_f8v2_phase(LAS unsigned char* lds, const Gemm g, const Sched& S, const Epi& E) {
    int tid = threadIdx.x; asm volatile("" : "+v"(tid));
    const int wid = __builtin_amdgcn_readfirstlane(tid >> 6), lane = tid & 63, wr4 = wid >> 1, wc2 = wid & 1, fr = lane & 15, fq = lane >> 4;
    const int K = g.K, nt = K / BK;
    unsigned voffA[2], voffB[2];
#pragma unroll
    for (int i = 0; i < 2; ++i) { int R, C; stage_rc(tid * 16 + i * 8192, R, C); const int Rb = (R & ~31) + perm32(R & 31);
        voffA[i] = (unsigned)(R * K + C) * 2u; voffB[i] = (unsigned)(Rb * K + C) * 2u; }
    const size_t kstep = (size_t)(BK * 2);
    const size_t hstep = (size_t)HALF * K * 2;
    const size_t tstep = 2 * hstep;
    const unsigned ldsw = (unsigned)wid * 1024u;
    constexpr int BUFB = 3 * HTB;
    const int aoff = (wr4 >> 1) * HTB + lds_byte((wr4 & 1) * 64 + fr, fq * 8), boff = 2 * HTB + lds_byte(wc2 * 64 + fr, fq * 8);
    const int scw = SCW * 0x01010101, scx = SCX * 0x01010101;
#define F8_STAGE(ldsoff, gbase, voff) do { _Pragma("unroll") for (int _i = 0; _i < 2; ++_i) \
        __builtin_amdgcn_global_load_lds((const unsigned*)((const char*)(gbase) + (voff)[_i]), (LAS unsigned*)(lds + (ldsoff) + ldsw + _i * 8192), 16, 0, 0); } while (0)
#define F8_STAGE3(bufoff, pa, pb) do { F8_STAGE((bufoff), (pa), voffA); F8_STAGE((bufoff) + HTB, (pa) + hstep, voffA); F8_STAGE((bufoff) + 2 * HTB, (pb), voffB); } while (0)
#define F8_LD16(off) (*(const LAS i32x4*)(lds + (off)))
#define F8_LDF(dst, base, k) dst = __builtin_shufflevector(F8_LD16((base) + (k) * 2048), F8_LD16(((base) ^ 64) + (k) * 2048), 0, 1, 2, 3, 4, 5, 6, 7)
#define F8_MMA(CA, CB, m, q) acc[m][q] = __builtin_amdgcn_mfma_scale_f32_16x16x128_f8f6f4(CB[q], CA[m], acc[m][q], FMT, FMT, 0, scw, 0, scx)
#define F8_WAIT_V(n) asm volatile("s_waitcnt vmcnt(" #n ")" ::: "memory")
#define F8_WAIT_L(n) asm volatile("s_waitcnt lgkmcnt(" #n ")" ::: "memory")
#define F8_SCHED __builtin_amdgcn_sched_barrier(0)
#define F8_PIN(m) asm volatile("" : "+v"(acc[m][0]), "+v"(acc[m][1]), "+v"(acc[m][2]), "+v"(acc[m][3]))
#define F8_PIECE(ldsoff, gbase, voff, i) __builtin_amdgcn_global_load_lds((const unsigned*)((const char*)(gbase) + (voff)[i]), (LAS unsigned*)(lds + (ldsoff) + ldsw + (i) * 8192), 16, 0, 0)
#define F8_TILE(CA, CB, NA, NB) do { \
        F8_WAIT_L(0); F8_SCHED; __builtin_amdgcn_s_setprio(1); \
          \
        F8_MMA(CA, CB, 0, 0); F8_MMA(CA, CB, 0, 1); F8_MMA(CA, CB, 0, 2); F8_MMA(CA, CB, 0, 3); F8_SCHED; \
        F8_WAIT_V(6); __builtin_amdgcn_s_barrier(); \
        { const bool w_ = (dt == nt); dA = w_ ? nA : dA; dB = w_ ? nB : dB; dt = w_ ? 0 : dt; } \
        { const int db_ = bufc * BUFB; bufc = (bufc == 2) ? 0 : bufc + 1; const int ra_ = aoff + bufc * BUFB, rb_ = boff + bufc * BUFB; F8_SCHED; \
            \
          F8_MMA(CA, CB, 1, 0); F8_MMA(CA, CB, 1, 1); F8_LDF(NB[0], rb_, 0); F8_LDF(NA[0], ra_, 0); F8_SCHED; F8_MMA(CA, CB, 1, 2); F8_MMA(CA, CB, 1, 3); F8_LDF(NB[1], rb_, 1); F8_LDF(NB[2], rb_, 2); F8_SCHED; \
          F8_MMA(CA, CB, 2, 0); F8_MMA(CA, CB, 2, 1); F8_LDF(NB[3], rb_, 3); F8_LDF(NA[1], ra_, 1); F8_PIECE(db_, dA, voffA, 0); F8_SCHED; F8_MMA(CA, CB, 2, 2); F8_MMA(CA, CB, 2, 3); F8_LDF(NA[2], ra_, 2); F8_LDF(NA[3], ra_, 3); F8_PIECE(db_, dA, voffA, 1); F8_SCHED; \
          F8_MMA(CA, CB, 3, 0); F8_MMA(CA, CB, 3, 1); F8_PIECE(db_ + HTB, dA + hstep, voffA, 0); F8_PIECE(db_ + HTB, dA + hstep, voffA, 1); F8_SCHED; F8_MMA(CA, CB, 3, 2); F8_MMA(CA, CB, 3, 3); F8_PIECE(db_ + 2 * HTB, dB, voffB, 0); F8_PIECE(db_ + 2 * HTB, dB, voffB, 1); F8_SCHED; \
          __builtin_amdgcn_s_setprio(0); F8_PIN(0); F8_PIN(1); F8_PIN(2); F8_PIN(3); } \
        dA += kstep; dB += kstep; ++dt; \
    } while (0)
    Unit cur, nxt; int ui = 0;
    if (!S.next(0, cur)) return;
    f32x4 acc[4][4];
#pragma unroll
    for (int m = 0; m < 4; ++m)
#pragma unroll
        for (int q = 0; q < 4; ++q) acc[m][q] = (f32x4){0.f, 0.f, 0.f, 0.f};
    v8i32 A0[4], B0[4], A1[4], B1[4];
    const char* cA = (const char*)g.A + (size_t)cur.pm * tstep; const char* cB = (const char*)g.Bt + (size_t)cur.bt * hstep;
    int bufc = 0, dt = 3;
    F8_STAGE3(0, cA, cB); F8_STAGE3(BUFB, cA + kstep, cB + kstep); F8_STAGE3(2 * BUFB, cA + 2 * kstep, cB + 2 * kstep);
    const char* dA = cA + 3 * kstep; const char* dB = cB + 3 * kstep;
    F8_WAIT_V(12); __builtin_amdgcn_s_barrier();
#pragma unroll
    for (int k = 0; k < 4; ++k) { F8_LDF(B0[k], boff, k); F8_LDF(A0[k], aoff, k); }
    for (;;) {
        const bool has_next = S.next(ui + 1, nxt);
        const char* nA = has_next ? (const char*)g.A + (size_t)nxt.pm * tstep : cA; const char* nB = has_next ? (const char*)g.Bt + (size_t)nxt.bt * hstep : cB;
#pragma unroll 1
        for (int t = 0; t < nt; t += 2) {
            F8_TILE(A0, B0, A1, B1);
            F8_TILE(A1, B1, A0, B0);
        }
        E(acc, cur, wr4, wc2, fr, fq);
        if (!has_next) break;
#pragma unroll
        for (int m = 0; m < 4; ++m)
#pragma unroll
            for (int q = 0; q < 4; ++q) acc[m][q] = (f32x4){0.f, 0.f, 0.f, 0.f};
        cur = nxt; cA = nA; cB = nB; ++ui;
    }
    F8_WAIT_V(0); F8_WAIT_L(0);
    __builtin_amdgcn_s_barrier();
#undef F8_STAGE
#undef F8_STAGE3
#undef F8_LD16
#undef F8_LDF
#undef F8_MMA
#undef F8_WAIT_V
#undef F8_WAIT_L
#undef F8_SCHED
#undef F8_TILE
#undef F8_PIECE
#undef F8_PIN
}

typedef f32x4 Acc[2][2][4][2];
DI void st16wt(void* p, const u32x4 v) { asm volatile("global_store_dwordx4 %0, %1, off sc1\n\ts_nop 1" :: "v"(p), "v"(v) : "memory"); }
DI u32x4 pack8(const f32x4 a, const f32x4 b) { u32x4 w; w.x = cvtpk(a[0], a[1]); w.y = cvtpk(a[2], a[3]); w.z = cvtpk(b[0], b[1]); w.w = cvtpk(b[2], b[3]); return w; }

struct EpiInProj {
    static constexpr bool PERM = true, HAS_MID = false; static constexpr int MID_T = 0;
    bf16_t* qkv;
    const f32x2* rope;
    DI void mid(Acc&, const Unit&, int, int, int, int) const {}
    DI void operator()(Acc& acc, const Unit& u, int wr, int wc, int fr, int fq) const {
 asm volatile("" : "+v"(fr), "+v"(fq));
               const int pn = u.pn, row0 = u.pm * BM + wr * 64 + fr;
        if (pn >= 12 && pn < 20) {
            const int tsel = (pn < 16) ? 3 : 4; const float sc = (pn < 16) ? C_DA : 1.f;
            bf16_t* dst = qkv + (size_t)tsel * NTOK * 1024; const int col0 = ((pn - 12) & 3) * 256 + wc * 64 + 8 * fq;
            f32x4 st[4], cs0[4], cs1[4];
            { const f32x4* sp = (const f32x4*)(rope + (size_t)16 * 32 + 8 * fq); const f32x4* p0 = (const f32x4*)(rope + (size_t)(row0 & (SEQ - 1)) * 32 + 8 * fq);
              const f32x4* p1 = (const f32x4*)(rope + (size_t)((row0 + HALF) & (SEQ - 1)) * 32 + 8 * fq);
#pragma unroll
              for (int k = 0; k < 4; ++k) { st[k] = sp[k]; cs0[k] = p0[k]; cs1[k] = p1[k]; } }
#pragma unroll
            for (int ai = 0; ai < 2; ++ai) { f32x4 cs[4];
#pragma unroll
                for (int k = 0; k < 4; ++k) cs[k] = ai ? cs1[k] : cs0[k];
#pragma unroll
                for (int m = 0; m < 4; ++m) {
                    if (m > 0) {
#pragma unroll
                        for (int k = 0; k < 4; ++k) { const f32x4 c = cs[k], d = st[k];
                            cs[k] = (f32x4){c[0] * d[0] - c[1] * d[1], c[1] * d[0] + c[0] * d[1], c[2] * d[2] - c[3] * d[3], c[3] * d[2] + c[2] * d[3]}; } }
#pragma unroll
                    for (int n = 0; n < 2; ++n) { const f32x4 c0 = cs[2 * n], c1 = cs[2 * n + 1]; const f32x4 xl = acc[ai][0][m][n], xh = acc[ai][1][m][n];
                        const float co[4] = {c0[0], c0[2], c1[0], c1[2]}, si[4] = {c0[1], c0[3], c1[1], c1[3]};
#pragma unroll
                        for (int j = 0; j < 4; ++j) { acc[ai][0][m][n][j] = (xl[j] * co[j] - xh[j] * si[j]) * sc; acc[ai][1][m][n][j] = (xh[j] * co[j] + xl[j] * si[j]) * sc; } }
                    bf16_t* rowp = dst + (size_t)(row0 + ai * HALF + m * 16) * 1024 + col0;
                    st16wt(rowp, pack8(acc[ai][0][m][0], acc[ai][0][m][1])); st16wt(rowp + 32, pack8(acc[ai][1][m][0], acc[ai][1][m][1])); } }
        } else {
            const int tsel = (pn < 12) ? (pn >> 2) : 5; const float sc = (pn < 4) ? C_SB : 1.f;
            bf16_t* dst = qkv + (size_t)tsel * NTOK * 1024; const int col0 = (pn & 3) * 256 + wc * 32 + 8 * fq;
#pragma unroll
            for (int ai = 0; ai < 2; ++ai)
#pragma unroll
                for (int m = 0; m < 4; ++m) { bf16_t* rowp = dst + (size_t)(row0 + ai * HALF + m * 16) * 1024 + col0;
#pragma unroll
                    for (int bj = 0; bj < 2; ++bj) st16wt(rowp + bj * HALF, pack8(acc[ai][bj][m][0] * sc, acc[ai][bj][m][1] * sc)); }
        }
    }
};

struct EpiMerged {
    static constexpr bool PERM = true, HAS_MID = true; static constexpr int MID_T = 16;
    const bf16_t* gsb; const bf16_t* gda; bf16_t* merged;
    DI void mid(Acc& acc, const Unit& u, int wr, int wc, int fr, int fq) const {
        asm volatile("" : "+v"(fr), "+v"(fq));
        const int row0 = u.pm * BM + wr * 64 + fr, col0 = u.pn * BM + wc * 32 + 8 * fq;
        u32x4 a[2][4][2];
#pragma unroll
        for (int ai = 0; ai < 2; ++ai)
#pragma unroll
            for (int m = 0; m < 4; ++m) { const size_t off = (size_t)(row0 + ai * HALF + m * 16) * 2048 + col0;
#pragma unroll
                for (int bj = 0; bj < 2; ++bj) a[ai][m][bj] = *(const u32x4*)(gsb + off + bj * HALF); }
        asm volatile("" ::: "memory");
#pragma unroll
        for (int ai = 0; ai < 2; ++ai)
#pragma unroll
            for (int m = 0; m < 4; ++m)
#pragma unroll
                for (int bj = 0; bj < 2; ++bj)
#pragma unroll
                    for (int w = 0; w < 4; ++w) { acc[ai][bj][m][w >> 1][(w & 1) * 2] *= bflo(a[ai][m][bj][w]); acc[ai][bj][m][w >> 1][(w & 1) * 2 + 1] *= bfhi(a[ai][m][bj][w]); }
        asm volatile("" ::: "memory");
    }
    DI void operator()(Acc& acc, const Unit& u, int wr, int wc, int fr, int fq) const {
        asm volatile("" : "+v"(fr), "+v"(fq));
        const int row0 = u.pm * BM + wr * 64 + fr, col0 = u.pn * BM + wc * 32 + 8 * fq;
        u32x4 b[2][4][2];
#pragma unroll
        for (int ai = 0; ai < 2; ++ai)
#pragma unroll
            for (int m = 0; m < 4; ++m) { const size_t off = (size_t)(row0 + ai * HALF + m * 16) * 2048 + col0;
#pragma unroll
                for (int bj = 0; bj < 2; ++bj) b[ai][m][bj] = *(const u32x4*)(gda + off + bj * HALF); }
        asm volatile("" ::: "memory");
#pragma unroll
        for (int ai = 0; ai < 2; ++ai)
#pragma unroll
            for (int m = 0; m < 4; ++m) { const size_t off = (size_t)(row0 + ai * HALF + m * 16) * 2048 + col0;
#pragma unroll
                for (int bj = 0; bj < 2; ++bj) { const u32x4 g = b[ai][m][bj]; f32x4 v0 = acc[ai][bj][m][0], v1 = acc[ai][bj][m][1];
                    v0[0] *= bflo(g[0]); v0[1] *= bfhi(g[0]); v0[2] *= bflo(g[1]); v0[3] *= bfhi(g[1]); v1[0] *= bflo(g[2]); v1[1] *= bfhi(g[2]); v1[2] *= bflo(g[3]); v1[3] *= bfhi(g[3]);
                    *(u32x4*)(merged + off + bj * HALF) = pack8(v0, v1); } }
    }
};

struct EpiX1 {
    static constexpr bool PERM = true, HAS_MID = false; static constexpr int MID_T = 0;
    const float* x; bf16_t* x1b; float* ssq;
    DI void mid(Acc&, const Unit&, int, int, int, int) const {}
    DI void operator()(Acc& acc, const Unit& u, int wr, int wc, int fr, int fq) const {
        asm volatile("" : "+v"(fr), "+v"(fq));
        const int row0 = u.pm * BM + wr * 64 + fr, col0 = u.pn * BM + wc * 32 + 8 * fq;
        float sq[2][4];
#pragma unroll
        for (int ai = 0; ai < 2; ++ai) { f32x4 xv[4][2][2];
#pragma unroll
            for (int m = 0; m < 4; ++m) { const size_t off = (size_t)(row0 + ai * HALF + m * 16) * 2048 + col0;
#pragma unroll
                for (int bj = 0; bj < 2; ++bj) { xv[m][bj][0] = *(const f32x4*)(x + off + bj * HALF); xv[m][bj][1] = *(const f32x4*)(x + off + bj * HALF + 4); } }
            asm volatile("" ::: "memory");
#pragma unroll
            for (int m = 0; m < 4; ++m) { float s = 0.f;
#pragma unroll
                for (int bj = 0; bj < 2; ++bj) { const f32x4 v0 = acc[ai][bj][m][0] + xv[m][bj][0], v1 = acc[ai][bj][m][1] + xv[m][bj][1]; acc[ai][bj][m][0] = v0; acc[ai][bj][m][1] = v1;
                    s += (v0[0] * v0[0] + v0[1] * v0[1]) + (v0[2] * v0[2] + v0[3] * v0[3]) + (v1[0] * v1[0] + v1[1] * v1[1]) + (v1[2] * v1[2] + v1[3] * v1[3]); }
                s += swzx<16>(s); s = half_swap_sum(s); sq[ai][m] = s; }
            asm volatile("" ::: "memory"); }
#pragma unroll
        for (int ai = 0; ai < 2; ++ai)
#pragma unroll
            for (int m = 0; m < 4; ++m) { const int row = row0 + ai * HALF + m * 16; const size_t off = (size_t)row * 2048 + col0;
#pragma unroll
                for (int bj = 0; bj < 2; ++bj) *(u32x4*)(x1b + off + bj * HALF) = pack8(acc[ai][bj][m][0], acc[ai][bj][m][1]);
                if (fq == 0) ssq[(size_t)row * 32 + u.pn * 4 + wc] = sq[ai][m]; }
    }
};

struct EpiSwiglu2 {
    static constexpr int NST = 8;
    unsigned char* H;
    DI void operator()(AccQ& acc, const Unit& u, int wr4, int wc2, int fr, int fq) const {
        asm volatile("" : "+v"(fr), "+v"(fq));
        const int row0 = u.pm * BM + wr4 * 64 + fr, col0 = u.pn * 64 + wc2 * 32 + 4 * fq;
#pragma unroll
        for (int c2 = 0; c2 < 2; ++c2)
#pragma unroll
            for (int m = 0; m < 4; ++m) { float h[4];
#pragma unroll
                for (int j = 0; j < 4; ++j) { const float gt = acc[m][2 * c2][j], up = acc[m][2 * c2 + 1][j]; h[j] = gt * up * frcp(1.f + fexp2(-LOG2E * gt)); }
                *(unsigned*)(H + (size_t)(row0 + m * 16) * DE + col0 + 16 * c2) = pk4_fp8_sat(h[0], h[1], h[2], h[3]); }
    }
};
struct EpiGate2 {
    bf16_t* gsb; bf16_t* gda;
    DI void operator()(AccQ& acc, const Unit& u, int wr4, int wc2, int fr, int fq) const {
        asm volatile("" : "+v"(fr), "+v"(fq));
        const int row0 = u.pm * BM + wr4 * 64 + fr, col0 = u.pn * 64 + wc2 * 32 + 8 * fq;
#pragma unroll
        for (int m = 0; m < 4; ++m) { f32x4 r0, r1, d0, d1;
#pragma unroll
            for (int j = 0; j < 4; ++j) { const float ea0 = fexp2(-LOG2E * acc[m][0][j]), ea1 = fexp2(-LOG2E * acc[m][1][j]), eb0 = fexp2(-LOG2E * acc[m][2][j]), eb1 = fexp2(-LOG2E * acc[m][3][j]);
                r0[j] = (1.f + eb0) * frcp(1.f + ea0); r1[j] = (1.f + eb1) * frcp(1.f + ea1); d0[j] = frcp(1.f + eb0); d1[j] = frcp(1.f + eb1); }
            const size_t off = (size_t)(row0 + m * 16) * 2048 + col0;
            st16wt(gsb + off, pack8(r0, r1)); st16wt(gda + off, pack8(d0, d1)); }
    }
};
struct EpiDown2 {
    static constexpr int NST = 8;
    unsigned char* Y;
    DI void operator()(AccQ& acc, const Unit& u, int wr4, int wc2, int fr, int fq) const {
        asm volatile("" : "+v"(fr), "+v"(fq));
        const int row0 = u.pm * BM + wr4 * 64 + fr, col0 = u.pn * HALF + wc2 * 64 + 8 * fq;
#pragma unroll
        for (int c2 = 0; c2 < 2; ++c2)
#pragma unroll
            for (int m = 0; m < 4; ++m) { const f32x4 a = acc[m][2 * c2] * 32.f, b = acc[m][2 * c2 + 1] * 32.f; u32x2 w; w.x = pk4_fp8_sat(a[0], a[1], a[2], a[3]); w.y = pk4_fp8_sat(b[0], b[1], b[2], b[3]);
                *(u32x2*)(Y + (size_t)(row0 + m * 16) * 2048 + col0 + 32 * c2) = w; }
    }
};
}

namespace att {
#define MFMA32(a, b, c) __builtin_amdgcn_mfma_f32_32x32x16_bf16((a), (b), (c), 0, 0, 0)
#define SBAR() __builtin_amdgcn_sched_barrier(0)
#define WAIT_BAR() asm volatile("s_waitcnt vmcnt(0) lgkmcnt(0)\n\ts_barrier" ::: "memory")
DI int crow(int r, int h) { return (r & 3) + 8 * (r >> 2) + 4 * h; }
DI int img_off(int row, int ch) { return 256 * row + 16 * (ch ^ (((row & 3) << 2) | ((row >> 2) & 3))); }
constexpr int TKEYS = 128, L_BUF = 65536, L_V = 32768, L_STG = 0, L_WSF = 131072 + 2048, L_FLAG = 131072 + 1024;
typedef short v4i16_t __attribute__((ext_vector_type(4)));
DI s16x4 tr16(const LAS unsigned char* p) { return __builtin_bit_cast(s16x4, __builtin_amdgcn_ds_read_tr16_b64_v4i16((LAS v4i16_t*)p)); }
template <int X> DI float swz_xor(float v) { return __uint_as_float((unsigned)__builtin_amdgcn_ds_swizzle((int)__float_as_uint(v), (X << 10) | 0x1F)); }
DI float xhalf_sum(float v) { auto rr = __builtin_amdgcn_permlane32_swap(__float_as_uint(v), __float_as_uint(v), false, false); return __uint_as_float(rr[0]) + __uint_as_float(rr[1]); }
DI float max3f(float a, float b, float c) { return __builtin_elementwise_maximum(__builtin_elementwise_maximum(a, b), c); }
DI float xhalf_max(float v) { auto rr = __builtin_amdgcn_permlane32_swap(__float_as_uint(v), __float_as_uint(v), false, false); return fmaxf(__uint_as_float(rr[0]), __uint_as_float(rr[1])); }
DI void glds16(const void* gbase, unsigned voff, unsigned lds_dst) { unsigned keep;
    asm volatile("s_nop 4\n\ts_mov_b32 %0, m0\n\ts_mov_b32 m0, %3\n\ts_nop 0\n\tglobal_load_lds_dwordx4 %1, %2\n\ts_mov_b32 m0, %0" : "=&s"(keep) : "v"(voff), "s"(gbase), "s"(lds_dst) : "memory"); }
DI void tile_offs(unsigned (&voff)[4], int wid, int lane) {
#pragma unroll
    for (int i4 = 0; i4 < 4; ++i4) { const int pc = i4 * 8 + wid, row = pc * 4 + (lane >> 4), f = ((lane >> 4) << 2) | (pc & 3); voff[i4] = (unsigned)(row * 2048 + (((lane & 15) ^ f) * 16)); }
}
template <int I0 = 0, int I1 = 4> DI void tile_issue(const bf16_t* Kt, const bf16_t* Vt, const unsigned (&voff)[4], unsigned bufaddr, int wid) {
#pragma unroll
    for (int i4 = I0; i4 < I1; ++i4) { const int pc = i4 * 8 + wid;
        glds16(Kt, voff[i4], (unsigned)__builtin_amdgcn_readfirstlane((int)(bufaddr + pc * 1024)));
        glds16(Vt, voff[i4], (unsigned)__builtin_amdgcn_readfirstlane((int)(bufaddr + L_V + pc * 1024))); }
}
DI bf16x8 kfrag(const LAS unsigned char* kimg, int kb  , int f  , int h, int sub, int st) { return *(const LAS bf16x8*)(kimg + kb + 8192 * sub + 16 * ((2 * st + h) ^ f)); }
DI bf16x8 vfrag(const LAS unsigned char* vimg, int vb  , int cx  , int q, int n, int sub, int s) {
    const int ch = (((n ^ q) << 2) | cx) * 16;
    const s16x4 lo = tr16(vimg + vb + ch + 256 * (32 * sub + 16 * s));
    const s16x4 hi = tr16(vimg + vb + (ch ^ 32) + 256 * (32 * sub + 16 * s + 8));
    return __builtin_shufflevector(lo, hi, 0, 1, 2, 3, 4, 5, 6, 7);
}
DI bf16x8 pack_p(const f32x16& p, int s) { u32x4 w; w.x = cvtpk(p[8 * s], p[8 * s + 1]); w.y = cvtpk(p[8 * s + 2], p[8 * s + 3]); w.z = cvtpk(p[8 * s + 4], p[8 * s + 5]); w.w = cvtpk(p[8 * s + 6], p[8 * s + 7]); return __builtin_bit_cast(bf16x8, w); }

DI void store_tile(const f32x16 (&o)[4], LAS unsigned char* stg, bf16_t* dst  , int ldo, int lane, int r, int h) {
#pragma unroll
    for (int i = 0; i < 16; ++i) { const int q = crow(i, h);
#pragma unroll
        for (int n = 0; n < 4; ++n) { const unsigned w = cvtpk(o[n][i], 0.f); *(LAS unsigned short*)(stg + q * 256 + (32 * n + r) * 2) = (unsigned short)w; } }
    asm volatile("s_waitcnt lgkmcnt(0)" ::: "memory");
#pragma unroll
    for (int it = 0; it < 8; ++it) { const int idx = it * 64 + lane, row = idx >> 4, ch = idx & 15; const u32x4 v = *(const LAS u32x4*)(stg + row * 256 + ch * 16);
        *(u32x4*)(dst + (size_t)row * ldo + ch * 8) = v; }
    asm volatile("s_waitcnt lgkmcnt(0)" ::: "memory");
}
struct LaneC { int r, h, kb, kfx, vb, cx, q4; };
DI LaneC lane_consts(int lane) { LaneC c; c.r = lane & 31; c.h = lane >> 5; c.kb = 256 * c.r; c.kfx = ((c.r & 3) << 2) | ((c.r >> 2) & 3);
    const int i16 = lane & 15, p4 = i16 & 3, gi = (lane >> 4) & 1; c.q4 = i16 >> 2; c.vb = 256 * (4 * c.h + c.q4) + 8 * (p4 & 1); c.cx = (2 * gi + (p4 >> 1)) ^ c.h; return c; }

template <bool DIAG> DI void sb_sub(const LAS unsigned char* kimg, const LAS unsigned char* vimg, int sub, const LaneC& c, const bf16x8 (&qf)[8], f32x16 (&o)[4], float& carry) {
    f32x16 s = {};
    bf16x8 kf[8];
#pragma unroll
    for (int st = 0; st < 8; ++st) kf[st] = kfrag(kimg, c.kb, c.kfx, c.h, sub, st);
    SBAR();
#pragma unroll
    for (int st = 0; st < 8; ++st) s = MFMA32(kf[st], qf[st], s);
    SBAR();
    float be[16], om[16];
#pragma unroll
    for (int i = 0; i < 16; ++i) { const float zt = s[i], t = fexp2(-fabsf(zt)), rr = frcp(1.f + t), sm = t * rr; const bool pos = zt >= 0.f;
        be[i] = pos ? rr : sm; om[i] = pos ? sm : rr;
        if (DIAG && !(crow(i, c.h) < c.r)) { be[i] = 0.f; om[i] = 1.f; } }
    SBAR();
    bf16x8 vf[8];
#pragma unroll
    for (int n = 0; n < 4; ++n) { vf[2 * n] = vfrag(vimg, c.vb, c.cx, c.q4, n, sub, 0); vf[2 * n + 1] = vfrag(vimg, c.vb, c.cx, c.q4, n, sub, 1); }
    float T[4]; f32x16 a;
#pragma unroll
    for (int g = 0; g < 4; ++g) { const float s2 = om[4 * g + 3], s1 = s2 * om[4 * g + 2], s0 = s1 * om[4 * g + 1]; T[g] = s0 * om[4 * g];
        a[4 * g + 3] = be[4 * g + 3]; a[4 * g + 2] = be[4 * g + 2] * s2; a[4 * g + 1] = be[4 * g + 1] * s1; a[4 * g] = be[4 * g] * s0; }
    float both[4], thi[4];
#pragma unroll
    for (int g = 0; g < 4; ++g) { auto rr = __builtin_amdgcn_permlane32_swap(__float_as_uint(T[g]), __float_as_uint(T[g]), false, false);
        thi[g] = __uint_as_float(rr[1]); both[g] = __uint_as_float(rr[0]) * thi[g]; }
    float G[4]; G[3] = carry; G[2] = G[3] * both[3]; G[1] = G[2] * both[2]; G[0] = G[1] * both[1];
#pragma unroll
    for (int g = 0; g < 4; ++g) { const float base = c.h == 0 ? G[g] * thi[g] : G[g];
#pragma unroll
        for (int k = 0; k < 4; ++k) a[4 * g + k] *= base; }
    carry = G[0] * both[0];
    const bf16x8 p0 = pack_p(a, 0), p1 = pack_p(a, 1);
    SBAR();
#pragma unroll
    for (int n = 0; n < 4; ++n) { o[n] = MFMA32(p0, vf[2 * n], o[n]); o[n] = MFMA32(p1, vf[2 * n + 1], o[n]);
    }
    SBAR();
}
DI void sb_unit(LAS unsigned char* lds, const bf16_t* Q, const bf16_t* K, const bf16_t* V, bf16_t* O  , int b, int hd, int qb, int useq) {
    int tid = threadIdx.x; asm volatile("" : "+v"(tid));
    const int lane = tid & 63, wid = __builtin_amdgcn_readfirstlane(tid >> 6); const LaneC c = lane_consts(lane);
    const size_t rowbase = (size_t)b * SEQ; const int t0 = qb * 256;
    const bf16_t* Kp = K + rowbase * 1024 + hd * 128; const bf16_t* Vp = V + rowbase * 1024 + hd * 128;
    const unsigned lbase = (unsigned)(size_t)lds;
    LAS int* flags = (LAS int*)(lds + L_FLAG + (useq & 1) * 32);
    if (lane == 0) flags[wid] = -1;
    const int jmax = 2 * qb + 1, mysub = 8 * qb + wid;
    unsigned voff[4]; tile_offs(voff, wid, lane);
    WAIT_BAR();
    tile_issue(Kp + (size_t)(TKEYS * jmax) * 1024, Vp + (size_t)(TKEYS * jmax) * 1024, voff, lbase, wid);
    bf16x8 qf[8];
    { const bf16_t* qrow = Q + (rowbase + t0 + 32 * wid + c.r) * 1024 + hd * 128 + 8 * c.h;
#pragma unroll
      for (int st = 0; st < 8; ++st) qf[st] = *(const bf16x8*)(qrow + 16 * st); }
    asm volatile("" : "+v"(qf[0]), "+v"(qf[1]), "+v"(qf[2]), "+v"(qf[3]), "+v"(qf[4]), "+v"(qf[5]), "+v"(qf[6]), "+v"(qf[7]));
    f32x16 o[4];
#pragma unroll
    for (int n = 0; n < 4; ++n) o[n] = (f32x16){};
    float carry = 1.f; int buf = 0; bool mydone = false;
    for (int j = jmax; j >= 0; --j) {
        WAIT_BAR();
        { const LAS i32x4* fl = (const LAS i32x4*)flags; const i32x4 fa = fl[0], fb = fl[1];
          const bool alldone = fa[0] > j && fa[1] > j && fa[2] > j && fa[3] > j && fb[0] > j && fb[1] > j && fb[2] > j && fb[3] > j;
          if (__builtin_amdgcn_readfirstlane((int)alldone)) break; }
        if (j > 0) tile_issue(Kp + (size_t)(TKEYS * (j - 1)) * 1024, Vp + (size_t)(TKEYS * (j - 1)) * 1024, voff, lbase + (buf ^ 1) * L_BUF, wid);
        const LAS unsigned char* kimg = lds + buf * L_BUF; const LAS unsigned char* vimg = kimg + L_V;
        if (!mydone) {
#pragma unroll
            for (int sub = 3; sub >= 0; --sub) { const int su = 4 * j + sub;
                if (su <= mysub) { if (su == mysub) sb_sub<true>(kimg, vimg, sub, c, qf, o, carry); else sb_sub<false>(kimg, vimg, sub, c, qf, o, carry); } }
            if (__all(carry == 0.f)) { mydone = true; if (lane == 0) flags[wid] = j; }
        }
        buf ^= 1;
    }
    WAIT_BAR();
    { int l2 = threadIdx.x & 63; asm volatile("" : "+v"(l2));
      store_tile(o, lds + L_STG + wid * 8192, O + (rowbase + t0 + 32 * wid) * 2048 + hd * 128, 2048, l2, l2 & 31, l2 >> 5); }
}

DI void da_rescale(f32x16 (&o)[4], LAS float* wsf, float f, int r, int h) {
    if (h == 0) wsf[r] = f;
    asm volatile("s_waitcnt lgkmcnt(0)" ::: "memory");
#pragma unroll
    for (int i = 0; i < 16; ++i) { const float fi = wsf[crow(i, h)];
#pragma unroll
        for (int n = 0; n < 4; ++n) o[n][i] *= fi; }
    asm volatile("s_waitcnt lgkmcnt(0)" ::: "memory");
}
DI void da_tile(const LAS unsigned char* kimg, const LAS unsigned char* vimg, int ci  , int mp, const LaneC& c, const bf16x8 (&qf)[4], f32x16 (&o)[4], f32x16& negm, float& m, float& l, bool& first, LAS float* wsf) {
    bf16x8 kf[8];
#pragma unroll
    for (int st = 0; st < 4; ++st) { kf[st] = kfrag(kimg, c.kb, c.kfx, c.h, 2 * ci, 4 * mp + st); kf[4 + st] = kfrag(kimg, c.kb, c.kfx, c.h, 2 * ci + 1, 4 * mp + st); }
    SBAR();
    f32x16 s0 = negm, s1 = negm;
#pragma unroll
    for (int st = 0; st < 4; ++st) { s0 = MFMA32(kf[st], qf[st], s0); s1 = MFMA32(kf[4 + st], qf[st], s1); }
    bf16x8 vf[8];
#pragma unroll
    for (int n = 0; n < 4; ++n) { vf[2 * n] = vfrag(vimg, c.vb, c.cx, c.q4, n, 2 * ci, 0); vf[2 * n + 1] = vfrag(vimg, c.vb, c.cx, c.q4, n, 2 * ci, 1); }
    SBAR();
    float rq[4];
#pragma unroll
    for (int k = 0; k < 4; ++k) { float r = max3f(s0[4 * k], s0[4 * k + 1], s0[4 * k + 2]); r = max3f(r, s0[4 * k + 3], s1[4 * k]); r = max3f(r, s1[4 * k + 1], s1[4 * k + 2]); rq[k] = max3f(r, s1[4 * k + 3], s1[4 * k + 3]); }
    float rm = max3f(max3f(rq[0], rq[1], rq[2]), rq[3], rq[3]);
    { auto rr = __builtin_amdgcn_permlane32_swap(__float_as_uint(rm), __float_as_uint(rm), false, false); rm = max3f(__uint_as_float(rr[0]), __uint_as_float(rr[1]), __uint_as_float(rr[1])); }
    if (first || __any(rm > 8.f)) {
        const float dl = first ? rm : fmaxf(rm, 0.f); m += dl;
#pragma unroll
        for (int i = 0; i < 16; ++i) { s0[i] -= dl; s1[i] -= dl; negm[i] = -m; }
        if (!first) { const float f = fexp2(-dl); l *= f; da_rescale(o, wsf, f, c.r, c.h); }
        first = false;
    }
    float acc = 0.f;
#pragma unroll
    for (int i = 0; i < 16; ++i) { s0[i] = fexp2(s0[i]); acc += s0[i]; }
    const bf16x8 p00 = pack_p(s0, 0), p01 = pack_p(s0, 1);
    SBAR();
    bf16x8 vg[8];
#pragma unroll
    for (int n = 0; n < 4; ++n) { o[n] = MFMA32(p00, vf[2 * n], o[n]); o[n] = MFMA32(p01, vf[2 * n + 1], o[n]);
        vg[2 * n] = vfrag(vimg, c.vb, c.cx, c.q4, n, 2 * ci + 1, 0); vg[2 * n + 1] = vfrag(vimg, c.vb, c.cx, c.q4, n, 2 * ci + 1, 1);
#pragma unroll
        for (int i = 4 * n; i < 4 * n + 4; ++i) { s1[i] = fexp2(s1[i]); acc += s1[i]; }
        SBAR(); }
    l += acc;
    const bf16x8 p10 = pack_p(s1, 0), p11 = pack_p(s1, 1);
    SBAR();
#pragma unroll
    for (int n = 0; n < 4; ++n) { o[n] = MFMA32(p10, vg[2 * n], o[n]); o[n] = MFMA32(p11, vg[2 * n + 1], o[n]); }
}
DI void da_unit(LAS unsigned char* lds, const bf16_t* Q, const bf16_t* K, const bf16_t* V, bf16_t* O  , const float* subg, int lamd  , int b, int hd, int qb  ) {
    int tid = threadIdx.x; asm volatile("" : "+v"(tid));
    const int lane = tid & 63, wid = __builtin_amdgcn_readfirstlane(tid >> 6), g = wid >> 1, mp = wid & 1; const LaneC c = lane_consts(lane);
    const size_t rowbase = (size_t)b * SEQ; const int t0 = qb * 128;
    const bf16_t* Kp = K + rowbase * 1024 + hd * 128; const bf16_t* Vp = V + rowbase * 1024 + hd * 128;
    const unsigned lbase = (unsigned)(size_t)lds;
    const int jlast = qb, myj = 2 * qb + (g >> 1);
    unsigned voff[4]; tile_offs(voff, wid, lane);
    WAIT_BAR();
    tile_issue(Kp, Vp, voff, lbase, wid);
    bf16x8 qf[4];
    { const bf16_t* qrow = Q + (rowbase + t0 + 32 * g + c.r) * 1024 + hd * 128 + 64 * mp + 8 * c.h;
#pragma unroll
      for (int st = 0; st < 4; ++st) qf[st] = *(const bf16x8*)(qrow + 16 * st); }
    asm volatile("" : "+v"(qf[0]), "+v"(qf[1]), "+v"(qf[2]), "+v"(qf[3]));
    LAS float* wsf = (LAS float*)(lds + L_WSF + wid * 256);
    f32x16 o[4];
#pragma unroll
    for (int n = 0; n < 4; ++n) o[n] = (f32x16){};
    float m = 0.f, l = 0.f; int buf = 0; bool first = true;
    f32x16 negm = {};
    for (int j = 0; j <= jlast; ++j) {
        WAIT_BAR();
        if (j < jlast) tile_issue<0, 2>(Kp + (size_t)(TKEYS * (j + 1)) * 1024, Vp + (size_t)(TKEYS * (j + 1)) * 1024, voff, lbase + (buf ^ 1) * L_BUF, wid);
        const LAS unsigned char* kimg = lds + buf * L_BUF;
        if (2 * j <= myj) da_tile(kimg, kimg + L_V, 0, mp, c, qf, o, negm, m, l, first, wsf);
        if (j < jlast) tile_issue<2, 4>(Kp + (size_t)(TKEYS * (j + 1)) * 1024, Vp + (size_t)(TKEYS * (j + 1)) * 1024, voff, lbase + (buf ^ 1) * L_BUF, wid);
        if (2 * j + 1 <= myj) da_tile(kimg, kimg + L_V, 1, mp, c, qf, o, negm, m, l, first, wsf);
        buf ^= 1;
    }
    WAIT_BAR();
    l = xhalf_sum(l);
    { int lb_ = lamd; asm volatile("" : "+s"(lb_)); const float lam = __uint_as_float((unsigned)lb_) + 0.2f;
      if (c.h == 0) wsf[c.r] = (mp ? lam : 1.f) * frcp(l); }
    asm volatile("s_waitcnt lgkmcnt(0)" ::: "memory");
#pragma unroll
    for (int i = 0; i < 16; ++i) { const float a = wsf[crow(i, c.h)];
#pragma unroll
        for (int n = 0; n < 4; ++n) o[n][i] *= a; }
    LAS float* stash = (LAS float*)(lds + L_STG + g * 16384);
    if (mp) {
#pragma unroll
        for (int i = 0; i < 16; ++i)
#pragma unroll
            for (int n = 0; n < 4; ++n) stash[(4 * i + n) * 64 + lane] = o[n][i];
    }
    WAIT_BAR();
    if (!mp) {
        float sg[4];
#pragma unroll
        for (int n = 0; n < 4; ++n) sg[n] = subg[32 * n + c.r] * 0.8f;
#pragma unroll
        for (int i = 0; i < 16; ++i) { float ss = 0.f;
#pragma unroll
            for (int n = 0; n < 4; ++n) { const float od = o[n][i] - stash[(4 * i + n) * 64 + lane]; o[n][i] = od; ss += od * od; }
            ss += swz_xor<1>(ss); ss += swz_xor<2>(ss); ss += swz_xor<4>(ss); ss += swz_xor<8>(ss); ss += swz_xor<16>(ss);
            const float rn = __builtin_amdgcn_rsqf(ss * (1.f / 128.f) + EPS);
#pragma unroll
            for (int n = 0; n < 4; ++n) o[n][i] *= rn * sg[n]; }
        asm volatile("s_waitcnt lgkmcnt(0)" ::: "memory");
        store_tile(o, lds + L_STG + g * 16384, O + (rowbase + t0 + 32 * g) * 2048 + 1024 + hd * 128, 2048, lane, c.r, c.h);
    }
}
#undef SBAR
#undef WAIT_BAR
}

constexpr size_t MiB = 1u << 20;
constexpr size_t WS_CTL = 0, CTL_ZERO_BYTES = 1 * MiB;
constexpr size_t WS_WINT = 1 * MiB;
constexpr size_t WS_WBRT = 41 * MiB;
constexpr size_t WS_WOUTT = 49 * MiB;
constexpr size_t WS_WGUT = 57 * MiB;
constexpr size_t WS_WDT = 185 * MiB;
constexpr size_t WS_WRT = 249 * MiB;
constexpr size_t WS_ROPE = 250 * MiB;
constexpr size_t WS_SSQ = 251 * MiB;
constexpr size_t WS_TOKINFO = 253 * MiB;
constexpr size_t WS_TOKW = WS_TOKINFO + 262144;
constexpr size_t WS_TOKPOS = WS_TOKW + 131072;
constexpr size_t WS_ROWGATE = WS_TOKPOS + 131072;
constexpr size_t WS_A = 254 * MiB;
constexpr size_t WS_B = 318 * MiB;
constexpr size_t WS_Y = 398 * MiB;
constexpr size_t WS_H = 558 * MiB;
constexpr size_t WS_END = 578 * MiB;
constexpr int CW_BAR = 4096, CW_CNT = 16384;

constexpr int RING_BYTES = 131072, LDSCTL_OFF = 147456, MISC_OFF = LDSCTL_OFF + 320, TST_OFF = LDSCTL_OFF + 512;
constexpr int LDS_BYTES = 147456 + 4096;

#define RLX_AGENT __ATOMIC_RELAXED, __HIP_MEMORY_SCOPE_AGENT
#define LDS_WAIT() asm volatile("s_waitcnt lgkmcnt(0)" ::: "memory")

#define XB_TMO      128
#define XB_XCNT(j)  (256  + 64 * (j))
#define XB_XSUB(j)  (1280 + 64 * (j))
#define XB_XGEN(j)  (2304 + 64 * (j))
#define XB_TOP      3328
#define XB_TOPGEN   3392
#define XCD_BAR_WORDS 3456
#define XB_SPIN_CAP (1u << 18)
DI unsigned xb_ld(unsigned* p)              { return __hip_atomic_load(p, __ATOMIC_RELAXED, __HIP_MEMORY_SCOPE_AGENT); }
DI unsigned xb_add(unsigned* p, unsigned v) { return __hip_atomic_fetch_add(p, v, __ATOMIC_RELAXED, __HIP_MEMORY_SCOPE_AGENT); }
DI unsigned xb_xcc_id() { return (unsigned)__builtin_amdgcn_s_getreg((3 << 11) | 20) & 0xFu; }
#define XB_SPIN(cond, bar) do { unsigned _sp = 0; while (cond) { __builtin_amdgcn_s_sleep(1); \
    if ((++_sp & 255u) == 0u) { if (xb_ld(&(bar)[XB_TMO])) break; if (_sp > XB_SPIN_CAP) { atomicAdd(&(bar)[XB_TMO], 1u); break; } } } } while (0)
struct XcdBarrier { unsigned* bar; unsigned x; volatile LAS unsigned* st; };
DI XcdBarrier xcd_barrier_post(unsigned* bar, volatile LAS unsigned* st) {
    XcdBarrier b; b.bar = bar; b.x = xb_xcc_id(); b.st = st;
    if (threadIdx.x == 0) (void)xb_add(&bar[XB_XCNT(b.x)], 1u);
    return b;
}
DI void xcd_barrier_complete(unsigned* bar, unsigned x, unsigned& nloc, unsigned& nx) {
    const unsigned G = gridDim.x * gridDim.y * gridDim.z;
    unsigned sum, cnt, mine, sp = 0u;
    for (;;) {
        sum = 0u; cnt = 0u; mine = 0u;
#pragma unroll
        for (unsigned j = 0; j < 16; ++j) { const unsigned c = xb_ld(&bar[XB_XCNT(j)]); sum += c; cnt += (c > 0u) ? 1u : 0u; mine = (j == x) ? c : mine; }
        if (sum == G) break;
        __builtin_amdgcn_s_sleep(1);
        if ((++sp & 255u) == 0u) { if (xb_ld(&bar[XB_TMO])) break; if (sp > XB_SPIN_CAP) { atomicAdd(&bar[XB_TMO], 1u); break; } }
    }
    nloc = mine > 0u ? mine : 1u; nx = cnt > 0u ? cnt : 1u;
}
DI void xcd_barrier(const XcdBarrier& b) {
    asm volatile("s_waitcnt vmcnt(0)" ::: "memory");
    __syncthreads();
    if (threadIdx.x == 0) {
        unsigned* bar = b.bar;
        __builtin_amdgcn_s_waitcnt(0);
        unsigned nloc = b.st[0], nx = b.st[1];
        if (nloc == 0u) { xcd_barrier_complete(bar, b.x, nloc, nx); b.st[0] = nloc; b.st[1] = nx; }
        const unsigned old = xb_add(&bar[XB_XSUB(b.x)], 1u);
        const unsigned gen = old / nloc;
        if (old + 1u == (gen + 1u) * nloc) {
            __builtin_amdgcn_fence(__ATOMIC_RELEASE, "agent");
            asm volatile("s_waitcnt vmcnt(0)" ::: "memory");
            const unsigned og = xb_add(&bar[XB_TOP], 1u);
            const unsigned tg = og / nx;
            if (og + 1u == (tg + 1u) * nx) xb_add(&bar[XB_TOPGEN], 1u);
            else XB_SPIN(xb_ld(&bar[XB_TOPGEN]) == tg, bar);
            __builtin_amdgcn_fence(__ATOMIC_ACQUIRE, "agent");
            asm volatile("s_waitcnt vmcnt(0)" ::: "memory");
        } else {
            XB_SPIN(xb_ld(&bar[XB_TOPGEN]) == gen, bar);
            __builtin_amdgcn_fence(__ATOMIC_ACQUIRE, "agent");
            asm volatile("s_waitcnt vmcnt(0)" ::: "memory");
        }
    }
    __syncthreads();
}

struct Args {
    const float* x; const float* mix_g; const float* w_in; const float* lq1; const float* lk1; const float* lq2; const float* lk2; const float* subg;
    const float* w_bsb; const float* w_bd; const float* w_out; const float* ffn_g; const float* w_gr; const float* w_er; const float* w_gate; const float* w_up; const float* w_down; const float* fin_g;
    float* out; unsigned char* ws;
};

template <int MODE> DI int drow_of(int n) {
    if (MODE == 1) { const int pn = n >> 8; if (pn < 12 || pn >= 20) return n; const int lc = n & 255; return (pn << 8) + 128 * ((lc >> 5) & 1) + 32 * (lc >> 6) + (lc & 31); }
    if (MODE == 2) return 256 * (n >> 7) + (n & 127);
    if (MODE == 3) return 256 * (n >> 7) + 128 + (n & 127);
    return n;
}
template <int MODE> DI void transpose_item(const float* W, int N, int k0, int n0, bf16_t* WT, int ldk, int koff, LAS unsigned char* scr, int lane) {
    const int g = lane >> 4, l16 = lane & 15;
    f32x4 v[16];
#pragma unroll
    for (int i = 0; i < 16; ++i) { const int kk = 8 * (i >> 1) + 2 * g + (i & 1); v[i] = __builtin_nontemporal_load((const f32x4*)(W + (size_t)(k0 + kk) * N + n0 + 4 * l16)); }
#pragma unroll
    for (int m = 0; m < 8; ++m)
#pragma unroll
        for (int jj = 0; jj < 4; ++jj) { const int n = 4 * l16 + jj; *(LAS unsigned*)(scr + n * 128 + (((4 * m + g) ^ ((l16 & 7) << 2)) * 4)) = cvtpk(v[2 * m][jj], v[2 * m + 1][jj]); }
    LDS_WAIT(); asm volatile("" ::: "memory");
#pragma unroll
    for (int it = 0; it < 8; ++it) { const int n = it * 8 + (lane >> 3), c = lane & 7; const u32x4 o = *(const LAS u32x4*)(scr + n * 128 + ((c ^ ((n >> 2) & 7)) * 16));
        *(u32x4*)(WT + (size_t)drow_of<MODE>(n0 + n) * ldk + koff + k0 + 8 * c) = o; }
    LDS_WAIT(); asm volatile("" ::: "memory");
}

template <int MODE> DI int drow8_of(int n) { if (MODE == 4) return 8 * (n >> 2) + (n & 3); if (MODE == 5) return 8 * (n >> 2) + 4 + (n & 3);
    if (MODE == 6) { const int t = n >> 11, cc = n & 2047; return 128 * (cc >> 6) + 64 * ((cc >> 5) & 1) + 32 * t + (cc & 31); }
    return n; }
template <int MODE> DI void transpose_item8(const float* W, int N, int k0, int n0, unsigned char* WT, int ldk, float scale, LAS unsigned char* scr, int lane) {
    const int g = lane >> 4, l16 = lane & 15;
    f32x4 v[16];
#pragma unroll
    for (int i = 0; i < 16; ++i) { const int kk = 16 * (i >> 2) + 4 * g + (i & 3); v[i] = __builtin_nontemporal_load((const f32x4*)(W + (size_t)(k0 + kk) * N + n0 + 4 * l16)); }
#pragma unroll
    for (int b = 0; b < 4; ++b)
#pragma unroll
        for (int jj = 0; jj < 4; ++jj) { const int n = 4 * l16 + jj; *(LAS unsigned*)(scr + n * 64 + (((4 * b + g) ^ l16) * 4)) = pk4_fp8(v[4 * b][jj] * scale, v[4 * b + 1][jj] * scale, v[4 * b + 2][jj] * scale, v[4 * b + 3][jj] * scale); }
    LDS_WAIT(); asm volatile("" ::: "memory");
#pragma unroll
    for (int it = 0; it < 4; ++it) { const int n = it * 16 + (lane >> 2), c = lane & 3, s = (n >> 2) & 15; u32x4 o;
#pragma unroll
        for (int t = 0; t < 4; ++t) o[t] = *(const LAS unsigned*)(scr + n * 64 + (((4 * c + t) ^ s) * 4));
        *(u32x4*)(WT + (size_t)drow8_of<MODE>(n0 + n) * ldk + k0 + 16 * c) = o; }
    LDS_WAIT(); asm volatile("" ::: "memory");
}

typedef float f32x16v __attribute__((ext_vector_type(16)));
DI void fp6_slot_store(unsigned char* rowp  , int s, const f32x16v lo, const f32x16v hi) {
    const auto d = __builtin_amdgcn_cvt_scalef32_2xpk16_fp6_f32(lo, hi, 1.0f);
    unsigned char* p = rowp + (s >> 2) * 128 + 16 * (s & 3);
    *(u32x4*)p = (u32x4){(unsigned)d[0], (unsigned)d[1], (unsigned)d[2], (unsigned)d[3]}; *(u32x2*)(p + 64) = (u32x2){(unsigned)d[4], (unsigned)d[5]};
}
DI void fp6_weight_item(const float* W, int N, int s, int n0, unsigned char* WT, float scale, int lane) {
    f32x16v lo, hi;
#pragma unroll
    for (int j = 0; j < 8; ++j)
#pragma unroll
        for (int i = 0; i < 4; ++i) { const float v = __builtin_nontemporal_load(W + (size_t)(4 * s + 256 * j + i) * N + n0 + lane) * scale; if (j < 4) lo[4 * j + i] = v; else hi[4 * (j - 4) + i] = v; }
    fp6_slot_store(WT + (size_t)drow8_of<6>(n0 + lane) * 2048, s, lo, hi);
}
DI void rms_row_bf16(const float* xrow, const f32x4 (&g)[8]  , bf16_t* orow, unsigned char* orow8, int lane) {
    const f32x4* xr = (const f32x4*)xrow + lane; f32x4 v[8]; float s = 0.f;
#pragma unroll
    for (int j = 0; j < 8; ++j) { v[j] = __builtin_nontemporal_load(xr + 64 * j); s += (v[j][0] * v[j][0] + v[j][1] * v[j][1]) + (v[j][2] * v[j][2] + v[j][3] * v[j][3]); }
    const float rs = __builtin_amdgcn_rsqf(wave_sum(s) * (1.f / DM) + EPS);
    u32x2* o8 = (u32x2*)orow + lane;
    f32x16v lo, hi;
#pragma unroll
    for (int j = 0; j < 8; ++j) { const f32x4 gg = g[j]; const float e0 = v[j][0] * rs * gg[0], e1 = v[j][1] * rs * gg[1], e2 = v[j][2] * rs * gg[2], e3 = v[j][3] * rs * gg[3];
        u32x2 w; w.x = cvtpk(e0, e1); w.y = cvtpk(e2, e3); o8[64 * j] = w;
        if (j < 4) { lo[4 * j] = 2.f * e0; lo[4 * j + 1] = 2.f * e1; lo[4 * j + 2] = 2.f * e2; lo[4 * j + 3] = 2.f * e3; } else { hi[4 * j - 16] = 2.f * e0; hi[4 * j - 15] = 2.f * e1; hi[4 * j - 14] = 2.f * e2; hi[4 * j - 13] = 2.f * e3; } }
    fp6_slot_store(orow8, lane, lo, hi);
}

constexpr int NWAVES = 8;
__global__ void __launch_bounds__(NWAVES * 64, 2) hybrid_fwd(Args args) {
    extern __shared__ __attribute__((aligned(16))) unsigned char lds_raw[];
    LAS unsigned char* lds = (LAS unsigned char*)lds_raw;
    const int tid = threadIdx.x, lane = tid & 63, wave = __builtin_amdgcn_readfirstlane(tid >> 6);
    const int G = gridDim.x, bx = blockIdx.x;
    const int vcu = (G % 8 == 0) ? (bx % 8) * (G / 8) + bx / 8 : bx;
#define KA_DECL const __attribute__((address_space(4))) Args* ka = (const __attribute__((address_space(4))) Args*)__builtin_amdgcn_kernarg_segment_ptr(); asm volatile("" : "+s"(ka)); \
    unsigned char* const ws = ka->ws; (void)ws; \
    int tid = threadIdx.x; asm volatile("" : "+v"(tid)); const int lane = tid & 63; (void)lane
#define P_WINT ((bf16_t*)(ws + WS_WINT))
#define P_WBRT ((bf16_t*)(ws + WS_WBRT))
#define P_WOUTT ((bf16_t*)(ws + WS_WOUTT))
#define P_WGUT8 ((unsigned char*)(ws + WS_WGUT))
#define P_WDT8 ((unsigned char*)(ws + WS_WDT))
#define P_WRT ((bf16_t*)(ws + WS_WRT))
#define P_ROPE ((f32x2*)(ws + WS_ROPE))
#define P_SSQ ((float*)(ws + WS_SSQ))
#define P_TOKINFO ((int*)(ws + WS_TOKINFO))
#define P_TOKW ((float*)(ws + WS_TOKW))
#define P_TOKPOS ((int*)(ws + WS_TOKPOS))
#define P_ROWGATE ((float*)(ws + WS_ROWGATE))
#define P_BUFA ((bf16_t*)(ws + WS_A))
#define P_BUFB ((bf16_t*)(ws + WS_B))
#define P_HB8 ((unsigned char*)(ws + WS_H))
#define P_XS8 ((unsigned char*)(ws + WS_B))
#define P_YB8 ((unsigned char*)(ws + WS_Y))
#define P_H8IN ((unsigned char*)(ws + (size_t)512 * MiB))
#define P_WING8 ((unsigned char*)(ws + WS_WINT + (size_t)24 * MiB))
#define P_GSB ((bf16_t*)ka->out)
#define P_GDA ((bf16_t*)ka->out + (size_t)NTOK * 2048)
#define P_CTAB ((int*)(ws + WS_CTL + 65536))
    volatile LAS unsigned* MISC = (volatile LAS unsigned*)(lds + MISC_OFF);
    LAS int* tstart = (LAS int*)(lds + TST_OFF);
    for (int u = tid; u < (LDS_BYTES - RING_BYTES) / 4; u += NWAVES * 64) ((LAS unsigned*)(lds + RING_BYTES))[u] = 0u;
    __syncthreads();
    XcdBarrier bar;
    { KA_DECL; bar = xcd_barrier_post((unsigned*)(ws + WS_CTL) + CW_BAR, MISC + 8); }
    const int gw = vcu * NWAVES + wave, NGW = G * NWAVES;

#if DBG_STAGE != 1
    if (PH(0)) for (int rep_ = 0; rep_ < kReps[0]; ++rep_) { KA_DECL;
        LAS unsigned char* scr = lds + wave * 16384;
        constexpr int I_IN = 32 * 96, I_G6 = 64 * 64, I_BR = 16 * 32, I_OUT = 32 * 32, I_G = 32 * 8, I_D = 8 * 32;
        constexpr int NITEMS = I_IN + I_G6 + 2 * I_BR + I_OUT + 32 * (2 * I_G + I_D);
        for (int it = gw; it < NITEMS; it += NGW) {
            int r = it;
            if (r < I_IN) { const int kb = r / 96, nb = r % 96; transpose_item<1>(ka->w_in, INC, 64 * kb, 64 * nb, P_WINT, 2048, 0, scr, lane); continue; } r -= I_IN;
            if (r < I_G6) { fp6_weight_item(ka->w_in + 6144, INC, r >> 6, 64 * (r & 63), P_WING8, 64.f, lane); continue; } r -= I_G6;
            if (r < I_BR) { const int kb = r / 32, nb = r % 32; transpose_item<0>(ka->w_bsb, 2048, 64 * kb, 64 * nb, P_WBRT, 2048, 0, scr, lane); continue; } r -= I_BR;
            if (r < I_BR) { const int kb = r / 32, nb = r % 32; transpose_item<0>(ka->w_bd, 2048, 64 * kb, 64 * nb, P_WBRT, 2048, 1024, scr, lane); continue; } r -= I_BR;
            if (r < I_OUT) { const int kb = r / 32, nb = r % 32; transpose_item<0>(ka->w_out, 2048, 64 * kb, 64 * nb, P_WOUTT, 2048, 0, scr, lane); continue; } r -= I_OUT;
            if (r < 32 * I_G) { const int e = r / I_G, q = r % I_G, kb = q / 8, nb = q % 8;
                transpose_item8<4>(ka->w_gate + (size_t)e * 2048 * 512, 512, 64 * kb, 64 * nb, P_WGUT8 + (size_t)e * 1024 * 2048, 2048, 64.f, scr, lane); continue; } r -= 32 * I_G;
            if (r < 32 * I_G) { const int e = r / I_G, q = r % I_G, kb = q / 8, nb = q % 8;
                transpose_item8<5>(ka->w_up + (size_t)e * 2048 * 512, 512, 64 * kb, 64 * nb, P_WGUT8 + (size_t)e * 1024 * 2048, 2048, 64.f, scr, lane); continue; } r -= 32 * I_G;
            { const int e = r / I_D, q = r % I_D, kb = q / 32, nb = q % 32;
                transpose_item8<0>(ka->w_down + (size_t)e * 512 * 2048, 2048, 64 * kb, 64 * nb, P_WDT8 + (size_t)e * 2048 * 512, 512, 32.f, scr, lane); }
        }
        for (int idx = bx * 512 + tid; idx < SEQ * 32; idx += G * 512) {
            const int pos = idx >> 5, i = idx & 31;
            const float invf = __builtin_amdgcn_exp2f(-(float)i * (13.287712379549449f / 32.f));
            const float ang = (float)pos * invf;
            double rev = (double)ang * 0.15915494309189535; rev -= __builtin_floor(rev);
            const float rf = (float)rev;
            P_ROPE[idx] = (f32x2){__builtin_amdgcn_cosf(rf), __builtin_amdgcn_sinf(rf)};
        }
        for (int idx = bx * 512 + tid; idx < 64 * 2048; idx += G * 512) {
            const int j = idx >> 11, k = idx & 2047; float v = 0.f;
            if (j < 4) v = ka->w_gr[k * 4 + j] * ka->ffn_g[k]; else if (j < 36) v = ka->w_er[k * 32 + (j - 4)] * ka->ffn_g[k];
            P_WRT[idx] = (bf16_t)(cvtpk(v, 0.f) & 0xffffu);
        }
        { f32x4 mg[8];
#pragma unroll
          for (int j = 0; j < 8; ++j) mg[j] = ((const f32x4*)ka->mix_g)[lane + 64 * j];
          for (int m = gw; m < NTOK; m += NGW) rms_row_bf16(ka->x + (size_t)m * DM, mg, P_BUFA + (size_t)m * DM, P_H8IN + (size_t)m * DM, lane); }
        xcd_barrier(bar);
    }

    if (PH(1)) for (int rep_ = 0; rep_ < kReps[1]; ++rep_) { KA_DECL;
#ifndef STAGGER_TICKS
#define STAGGER_TICKS 0
#endif
        if (STAGGER_TICKS) { const unsigned long long t0 = __builtin_amdgcn_s_memrealtime(), dl = (unsigned long long)(((bx >> 3) & 7) * STAGGER_TICKS);
            while (__builtin_amdgcn_s_memrealtime() - t0 < dl) __builtin_amdgcn_s_sleep(8); }
        { pg8::Gemm g{P_BUFA, P_WINT, NTOK, 6144, DM}; pg8::StaticOrder S; S.init(NTOK, 6144, G, bx);
          pg8::EpiInProj E{P_BUFB, P_ROPE};
          pg8::gemm_phase<pg8::EpiInProj, pg8::StaticOrder, true, true>(lds, g, S, E); }
        { pg8::Gemm g{(const bf16_t*)P_H8IN, (const bf16_t*)P_WING8, NTOK, 4096, DM / 2}; pg8::StaticOrder S; S.init(NTOK, 2 * 4096, G, bx);
          pg8::EpiGate2 E{P_GSB, P_GDA};
          pg8::gemm_f8v2_phase<pg8::EpiGate2, pg8::StaticOrder, 127 - 6, 127 - 1, 2>(lds, g, S, E); }
        xcd_barrier(bar);
    }

    if (PH(2)) for (int rep_ = 0; rep_ < kReps[2]; ++rep_) { KA_DECL;
        const float a = ka->lq1[lane] * ka->lk1[lane], b2 = ka->lq2[lane] * ka->lk2[lane];
        const int lamd = __builtin_amdgcn_readfirstlane((int)__float_as_uint(__expf(wave_sum(a)) - __expf(wave_sum(b2))));
        const bf16_t* qsb = P_BUFB; const bf16_t* ksb = P_BUFB + (size_t)NTOK * 1024; const bf16_t* vsb = P_BUFB + (size_t)2 * NTOK * 1024;
        const bf16_t* qda = P_BUFB + (size_t)3 * NTOK * 1024; const bf16_t* kda = P_BUFB + (size_t)4 * NTOK * 1024; const bf16_t* vda = P_BUFB + (size_t)5 * NTOK * 1024;
        for (int u = vcu; u < 256; u += G) {
            const int bh = u >> 2, pi = u & 3, b = bh >> 3, hd = bh & 7;
#ifndef ATT_MASK
#define ATT_MASK 3
#endif
            if (ATT_MASK & 1) for (int k = 0; k < 2 * REP_SB; ++k) att::sb_unit(lds, qsb, ksb, vsb, P_BUFA, b, hd, (k & 1) == 0 ? 7 - pi : pi, k);
            if (ATT_MASK & 2) for (int k = 0; k < 4 * REP_DA; ++k) att::da_unit(lds, qda, kda, vda, P_BUFA, ka->subg, lamd, b, hd, (k & 1) ? 2 * pi + ((k >> 1) & 1) : 15 - 2 * pi - ((k >> 1) & 1));
        }
        xcd_barrier(bar);
    }

    if (PH(3)) for (int rep_ = 0; rep_ < kReps[3]; ++rep_) { KA_DECL;
        pg8::Gemm g{P_BUFA, P_WBRT, NTOK, DM, DM}; pg8::StaticOrder S; S.init(NTOK, DM, G, bx);
        pg8::EpiMerged E{P_GSB, P_GDA, P_BUFB};
        pg8::gemm_phase<pg8::EpiMerged, pg8::StaticOrder, true, true>(lds, g, S, E);
        xcd_barrier(bar);
    }

    if (PH(4)) for (int rep_ = 0; rep_ < kReps[4]; ++rep_) { KA_DECL;
        pg8::Gemm g{P_BUFB, P_WOUTT, NTOK, DM, DM}; pg8::StaticOrder S; S.init(NTOK, DM, G, bx);
        pg8::EpiX1 E{ka->x, P_BUFA, P_SSQ};
        pg8::gemm_phase<pg8::EpiX1, pg8::StaticOrder, true, true>(lds, g, S, E);
        xcd_barrier(bar);
    }
#endif

#if DBG_STAGE == 0
    if (PH(5)) for (int rep_ = 0; rep_ < kReps[5]; ++rep_) { KA_DECL;
        constexpr int PSTR = 64 * 56;
        LAS float* part = (LAS float*)lds; LAS float* Lg = (LAS float*)(lds + 8 * PSTR * 4);
        LAS int* hist = (LAS int*)(lds + 131072);
        const int fr = lane & 15, fq = lane >> 4;
        for (int tb = bx; tb < NTOK / 64; tb += G) {
            if (tid < 32) hist[tid] = 0;
            const f32x4 sv = *(const f32x4*)(P_SSQ + (size_t)(tb * 64 + (tid >> 3)) * 32 + 4 * (tid & 7));
            bf16x8 bv[8][3];
            { const bf16_t* bp = P_WRT + (size_t)fr * DM + 256 * wave + 8 * fq;
#pragma unroll
              for (int kk = 0; kk < 8; ++kk)
#pragma unroll
                  for (int nt = 0; nt < 3; ++nt) bv[kk][nt] = *(const bf16x8*)(bp + (size_t)16 * nt * DM + 32 * kk); }
#pragma unroll 1
            for (int tp = 0; tp < 2; ++tp) {
                bf16x8 av[2][8]; f32x4 acc[2][3];
#pragma unroll
                for (int u = 0; u < 2; ++u) { const bf16_t* ap = P_BUFA + (size_t)(tb * 64 + 16 * (2 * tp + u) + fr) * DM + 256 * wave + 8 * fq;
#pragma unroll
                    for (int kk = 0; kk < 8; ++kk) av[u][kk] = *(const bf16x8*)(ap + 32 * kk);
#pragma unroll
                    for (int nt = 0; nt < 3; ++nt) acc[u][nt] = (f32x4){0.f, 0.f, 0.f, 0.f}; }
#pragma unroll
                for (int u = 0; u < 2; ++u)
#pragma unroll
                    for (int kk = 0; kk < 8; ++kk)
#pragma unroll
                        for (int nt = 0; nt < 3; ++nt) acc[u][nt] = __builtin_amdgcn_mfma_f32_16x16x32_bf16(av[u][kk], bv[kk][nt], acc[u][nt], 0, 0, 0);
#pragma unroll
                for (int u = 0; u < 2; ++u)
#pragma unroll
                    for (int nt = 0; nt < 3; ++nt)
#pragma unroll
                        for (int rg = 0; rg < 4; ++rg) part[wave * PSTR + (16 * (2 * tp + u) + 4 * fq + rg) * 56 + 16 * nt + fr] = acc[u][nt][rg];
            }
            __syncthreads();
            { const int t = tid >> 3, j = tid & 7;
              float ss = (sv[0] + sv[1]) + (sv[2] + sv[3]);
              ss += swzx<1>(ss); ss += swzx<2>(ss); ss += swzx<4>(ss);
              const float rsv = __builtin_amdgcn_rsqf(ss * (1.f / DM) + EPS);
#pragma unroll
              for (int i = 0; i < 6; ++i) { float v = 0.f;
#pragma unroll
                  for (int w = 0; w < 8; ++w) v += part[w * PSTR + t * 56 + j + 8 * i];
                  Lg[t * 64 + j + 8 * i] = v * rsv; } }
            __syncthreads();
            int ex0 = 0, ex1 = 0, lr0 = 0, lr1 = 0; float w0 = 0.f, w1 = 0.f; const bool router = (wave < 4 && lane < 16); const int tok0 = tb * 64 + 16 * wave;
            { LAS float* lg = Lg + 16 * wave * 64;
            if (router) {
                const LAS float* L = lg + lane * 64;
                float g0 = L[0]; int grp = 0;
#pragma unroll
                for (int j = 1; j < 4; ++j) { const float v = L[j]; if (v > g0) { g0 = v; grp = j; } }
                float den = 0.f;
#pragma unroll
                for (int j = 0; j < 4; ++j) den += __expf(L[j] - g0);
                const float pg = 1.f / den;
                const LAS float* E = L + 4 + 8 * grp;
                float v0 = E[0]; int i0 = 0;
#pragma unroll
                for (int j = 1; j < 8; ++j) { const float v = E[j]; if (v > v0) { v0 = v; i0 = j; } }
                float v1 = -3.0e38f; int i1 = 0;
#pragma unroll
                for (int j = 0; j < 8; ++j) { const float v = E[j]; if (j != i0 && v > v1) { v1 = v; i1 = j; } }
                const float e1 = __expf(v1 - v0); w0 = pg / (1.f + e1); w1 = pg * e1 / (1.f + e1);
                ex0 = grp * 8 + i0; ex1 = grp * 8 + i1;
                lr0 = __hip_atomic_fetch_add(hist + ex0, 1, __ATOMIC_RELAXED, __HIP_MEMORY_SCOPE_WORKGROUP); lr1 = __hip_atomic_fetch_add(hist + ex1, 1, __ATOMIC_RELAXED, __HIP_MEMORY_SCOPE_WORKGROUP);
            }
            LDS_WAIT(); asm volatile("" ::: "memory");
            }
            if (router) { const int t = tok0 + lane;
                *(int4*)(P_TOKINFO + 4 * (size_t)t) = make_int4(ex0, lr0, ex1, lr1);
                *(float2*)(P_TOKW + 2 * (size_t)t) = make_float2(w0, w1); }
            __syncthreads();
            if (tid < 32) P_CTAB[tb * 32 + tid] = hist[tid];
            __syncthreads();
        }
        xcd_barrier(bar);
    }

    if (PH(6)) for (int rep_ = 0; rep_ < kReps[6]; ++rep_) { KA_DECL;
        LAS int* ptab = (LAS int*)lds;
        static_assert(NTOK / 64 == 256, "one wave scans 256 blocks as 64 lanes x 4");
#pragma unroll
        for (int k = 0; k < 4; ++k) { const int e = 4 * wave + k;
            const int v0 = P_CTAB[(4 * lane) * 32 + e], v1 = P_CTAB[(4 * lane + 1) * 32 + e], v2 = P_CTAB[(4 * lane + 2) * 32 + e], v3 = P_CTAB[(4 * lane + 3) * 32 + e];
            const int s0 = v0, s1 = s0 + v1, s2 = s1 + v2, s3 = s2 + v3; int incl = s3;
#pragma unroll
            for (int d = 1; d < 64; d <<= 1) { const int n = __shfl_up(incl, d); if (lane >= d) incl += n; }
            const int ex = incl - s3;
            *(LAS i32x4*)(ptab + e * 256 + 4 * lane) = (i32x4){ex, ex + s0, ex + s1, ex + s2};
            if (lane == 63) ptab[8192 + e] = incl; }
        __syncthreads();
        if (wave == 0) { const int cnt = (lane < 32) ? (ptab[8192 + (lane & 31)] + 255) >> 8 : 0; int incl = cnt;
#pragma unroll
            for (int d = 1; d < 32; d <<= 1) { const int n = __shfl_up(incl, d); if (lane >= d) incl += n; }
            if (lane < 32) tstart[lane] = incl - cnt;
            if (lane == 31) tstart[32] = incl; }
        __syncthreads();
        f32x4 gq[8];
#pragma unroll
        for (int q = 0; q < 8; ++q) gq[q] = ((const f32x4*)ka->ffn_g + 8 * lane)[q];
        for (int t0 = gw; t0 < NTOK; t0 += 2 * NGW) {
            const int tt[2] = {t0, (t0 + NGW < NTOK) ? t0 + NGW : t0};
            int4 ti[2]; float sq[2]; u32x4 xv[2][4];
#pragma unroll
            for (int u = 0; u < 2; ++u) { ti[u] = *(const int4*)(P_TOKINFO + 4 * (size_t)tt[u]); sq[u] = (lane < 32) ? P_SSQ[(size_t)tt[u] * 32 + lane] : 0.f;
                const u32x4* src = (const u32x4*)(P_BUFA + (size_t)tt[u] * DM) + 4 * lane;
#pragma unroll
                for (int q = 0; q < 4; ++q) xv[u][q] = src[q]; }
#pragma unroll
            for (int u = 0; u < 2; ++u) {
                const int pb = tt[u] >> 6, pos0 = 256 * tstart[ti[u].x] + ptab[ti[u].x * 256 + pb] + ti[u].y, pos1 = 256 * tstart[ti[u].z] + ptab[ti[u].z * 256 + pb] + ti[u].w;
                const float rs = __builtin_amdgcn_rsqf(wave_sum(sq[u]) * (1.f / DM) + EPS);
                u32x4 o[2];
#pragma unroll
                for (int q = 0; q < 4; ++q) { const u32x4 v = xv[u][q]; const f32x4 g0 = gq[2 * q], g1 = gq[2 * q + 1];
                    const unsigned w0 = pk4_fp8_sat(bflo(v.x) * rs * g0[0], bfhi(v.x) * rs * g0[1], bflo(v.y) * rs * g0[2], bfhi(v.y) * rs * g0[3]);
                    const unsigned w1 = pk4_fp8_sat(bflo(v.z) * rs * g1[0], bfhi(v.z) * rs * g1[1], bflo(v.w) * rs * g1[2], bfhi(v.w) * rs * g1[3]);
                    o[q >> 1][(q & 1) * 2] = w0; o[q >> 1][(q & 1) * 2 + 1] = w1; }
                { u32x4* d0 = (u32x4*)(P_XS8 + (size_t)pos0 * DM) + 2 * lane; u32x4* d1 = (u32x4*)(P_XS8 + (size_t)pos1 * DM) + 2 * lane; d0[0] = o[0]; d0[1] = o[1]; d1[0] = o[0]; d1[1] = o[1]; }
                if (lane == 0) *(int2*)(P_TOKPOS + 2 * (size_t)tt[u]) = make_int2(pos0, pos1);
            }
        }
        xcd_barrier(bar);
    }

    if (PH(7)) for (int rep_ = 0; rep_ < kReps[7]; ++rep_) { KA_DECL;
        pg8::Gemm g{(const bf16_t*)P_XS8, (const bf16_t*)P_WGUT8, PROWS, 1024, DM / 2}; pg8::MoeOrder S{tstart, 8, G, bx};
        pg8::EpiSwiglu2 E{P_HB8};
        pg8::gemm_f8v2_phase<pg8::EpiSwiglu2, pg8::MoeOrder, 127 - 6, 127>(lds, g, S, E);
        xcd_barrier(bar);
    }

    if (PH(8)) for (int rep_ = 0; rep_ < kReps[8]; ++rep_) { KA_DECL;
        pg8::Gemm g{(const bf16_t*)P_HB8, (const bf16_t*)P_WDT8, PROWS, 2048, DE / 2}; pg8::MoeOrder S{tstart, 16, G, bx};
        pg8::EpiDown2 E{P_YB8};
        pg8::gemm_f8v2_phase<pg8::EpiDown2, pg8::MoeOrder, 127 - 5, 127>(lds, g, S, E);
        xcd_barrier(bar);
    }
#endif

    if (PH(9)) for (int rep_ = 0; rep_ < kReps[9]; ++rep_) { KA_DECL;
    f32x4 fg[8];
#pragma unroll
    for (int j = 0; j < 8; ++j) fg[j] = ((const f32x4*)ka->fin_g)[lane + 64 * j];
#if DBG_STAGE == 0
    for (int t0 = gw; t0 < NTOK; t0 += 2 * NGW) {
        const int tt[2] = {t0, (t0 + NGW < NTOK) ? t0 + NGW : t0};
        u32x2 xw[2][8]; unsigned ya[2][8], yb[2][8]; float wa[2], wb[2];
#pragma unroll
        for (int u = 0; u < 2; ++u) { const int2 tp = *(const int2*)(P_TOKPOS + 2 * (size_t)tt[u]); const float2 tw = *(const float2*)(P_TOKW + 2 * (size_t)tt[u]); wa[u] = tw.x * (1.f / 32.f); wb[u] = tw.y * (1.f / 32.f);
            const u32x2* xr = (const u32x2*)(P_BUFA + (size_t)tt[u] * DM) + lane; const unsigned* pa = (const unsigned*)(P_YB8 + (size_t)tp.x * DM) + lane; const unsigned* pb = (const unsigned*)(P_YB8 + (size_t)tp.y * DM) + lane;
#pragma unroll
            for (int j = 0; j < 8; ++j) { xw[u][j] = xr[64 * j]; ya[u][j] = pa[64 * j]; yb[u][j] = pb[64 * j]; } }
#pragma unroll
        for (int u = 0; u < 2; ++u) { f32x4 v[8]; float s = 0.f;
#pragma unroll
            for (int j = 0; j < 8; ++j) { const u32x2 w = xw[u][j]; const int a = (int)ya[u][j], b = (int)yb[u][j];
                const f32x2 a0 = __builtin_amdgcn_cvt_pk_f32_fp8(a, false), a1 = __builtin_amdgcn_cvt_pk_f32_fp8(a, true), b0 = __builtin_amdgcn_cvt_pk_f32_fp8(b, false), b1 = __builtin_amdgcn_cvt_pk_f32_fp8(b, true);
                v[j] = (f32x4){bflo(w.x) + (a0[0] * wa[u] + b0[0] * wb[u]), bfhi(w.x) + (a0[1] * wa[u] + b0[1] * wb[u]), bflo(w.y) + (a1[0] * wa[u] + b1[0] * wb[u]), bfhi(w.y) + (a1[1] * wa[u] + b1[1] * wb[u])};
                s += (v[j][0] * v[j][0] + v[j][1] * v[j][1]) + (v[j][2] * v[j][2] + v[j][3] * v[j][3]); }
            const float rs = __builtin_amdgcn_rsqf(wave_sum(s) * (1.f / DM) + EPS);
            if (u == 0 || tt[1] != tt[0]) { f32x4* orow = (f32x4*)(ka->out + (size_t)tt[u] * DM) + lane;
#pragma unroll
                for (int j = 0; j < 8; ++j) orow[64 * j] = v[j] * rs * fg[j]; } }
    }
#else
    for (int t = gw; t < NTOK; t += NGW) {
        f32x4 v[8];
#if DBG_STAGE == 1
        { const f32x4* xr = (const f32x4*)(ka->x + (size_t)t * DM) + lane;
#pragma unroll
          for (int j = 0; j < 8; ++j) v[j] = xr[64 * j]; }
#else
        { const u32x2* xr = (const u32x2*)(P_BUFA + (size_t)t * DM) + lane;
#if DBG_STAGE == 0
          const int2 tp = *(const int2*)(P_TOKPOS + 2 * (size_t)t); const float2 tw = *(const float2*)(P_TOKW + 2 * (size_t)t); const float wa = tw.x * (1.f / 32.f), wb = tw.y * (1.f / 32.f);
          const unsigned* ya = (const unsigned*)(P_YB8 + (size_t)tp.x * DM) + lane; const unsigned* yb = (const unsigned*)(P_YB8 + (size_t)tp.y * DM) + lane;
#endif
#pragma unroll
          for (int j = 0; j < 8; ++j) { const u32x2 w = xr[64 * j]; v[j] = (f32x4){bflo(w.x), bfhi(w.x), bflo(w.y), bfhi(w.y)};
#if DBG_STAGE == 0
              const int a = (int)ya[64 * j], b = (int)yb[64 * j];
              const f32x2 a0 = __builtin_amdgcn_cvt_pk_f32_fp8(a, false), a1 = __builtin_amdgcn_cvt_pk_f32_fp8(a, true), b0 = __builtin_amdgcn_cvt_pk_f32_fp8(b, false), b1 = __builtin_amdgcn_cvt_pk_f32_fp8(b, true);
              v[j] += (f32x4){a0[0] * wa + b0[0] * wb, a0[1] * wa + b0[1] * wb, a1[0] * wa + b1[0] * wb, a1[1] * wa + b1[1] * wb};
#endif
          } }
#endif
        float s = 0.f;
#pragma unroll
        for (int j = 0; j < 8; ++j) s += (v[j][0] * v[j][0] + v[j][1] * v[j][1]) + (v[j][2] * v[j][2] + v[j][3] * v[j][3]);
        const float rs = __builtin_amdgcn_rsqf(wave_sum(s) * (1.f / DM) + EPS);
        f32x4* orow = (f32x4*)(ka->out + (size_t)t * DM) + lane;
#pragma unroll
        for (int j = 0; j < 8; ++j) orow[64 * j] = v[j] * rs * fg[j];
    }
#endif
}
}

extern "C" void kernel_launch(void* const* d_in, const int* in_sizes, int n_in, void* d_out, int out_size, void* d_ws, size_t ws_size, hipStream_t stream) {
    static int grid = 0;
    if (grid == 0) {
        if (n_in != 18 || in_sizes[0] != NTOK * DM || out_size != NTOK * DM || ws_size < WS_END) {
            fprintf(stderr, "kernel_launch: unexpected shapes (n_in %d, in0 %d, out %d, ws %zu)\n", n_in, n_in > 0 ? in_sizes[0] : -1, out_size, ws_size); grid = -1; return; }
        int dev = 0, cus = 0;
        if (hipGetDevice(&dev) != hipSuccess || hipDeviceGetAttribute(&cus, hipDeviceAttributeMultiprocessorCount, dev) != hipSuccess) { grid = -1; return; }
        if (hipFuncSetAttribute((const void*)hybrid_fwd, hipFuncAttributeMaxDynamicSharedMemorySize, LDS_BYTES) != hipSuccess) { fprintf(stderr, "kernel_launch: hipFuncSetAttribute failed\n"); grid = -1; return; }
        int per_cu = 0;
        if (hipOccupancyMaxActiveBlocksPerMultiprocessor(&per_cu, (const void*)hybrid_fwd, NWAVES * 64, LDS_BYTES) != hipSuccess || per_cu < 1) { fprintf(stderr, "kernel_launch: occupancy query says %d\n", per_cu); }
        (void)hipGetLastError();
        grid = cus;
    }
    if (grid < 0) return;
    if (hipMemsetAsync((char*)d_ws + WS_CTL, 0, CTL_ZERO_BYTES, stream) != hipSuccess) return;
    Args a{};
    a.x = (const float*)d_in[0]; a.mix_g = (const float*)d_in[1]; a.w_in = (const float*)d_in[2]; a.lq1 = (const float*)d_in[3]; a.lk1 = (const float*)d_in[4];
    a.lq2 = (const float*)d_in[5]; a.lk2 = (const float*)d_in[6]; a.subg = (const float*)d_in[7]; a.w_bsb = (const float*)d_in[8]; a.w_bd = (const float*)d_in[9];
    a.w_out = (const float*)d_in[10]; a.ffn_g = (const float*)d_in[11]; a.w_gr = (const float*)d_in[12]; a.w_er = (const float*)d_in[13]; a.w_gate = (const float*)d_in[14];
    a.w_up = (const float*)d_in[15]; a.w_down = (const float*)d_in[16]; a.fin_g = (const float*)d_in[17];
    a.out = (float*)d_out; a.ws = (unsigned char*)d_ws;
    hipLaunchKernelGGL(hybrid_fwd, dim3(grid), dim3(NWAVES * 64), LDS_BYTES, stream, a);
}
```

```cpp
#include <hip/hip_runtime.h>
#include <cstdio>
#include <cstdint>

#ifndef DBG_STAGE
#define DBG_STAGE 0
#endif

#ifndef PH_MASK
#define PH_MASK 0x3ff
#endif
#define PH(k) ((PH_MASK >> (k)) & 1)
#ifndef REP_LIST
#define REP_LIST 1, 1, 1, 1, 1, 1, 1, 1, 1, 1
#endif
#ifndef REP_SB
#define REP_SB 1
#endif
#ifndef REP_DA
#define REP_DA 1
#endif
constexpr int kReps[10] = {REP_LIST};
#define DI __device__ __forceinline__
#define LAS __attribute__((address_space(3)))
#define GAS __attribute__((address_space(1)))
typedef unsigned short bf16_t;
typedef short bf16x8 __attribute__((ext_vector_type(8)));
typedef short s16x4 __attribute__((ext_vector_type(4)));
typedef float f32x2 __attribute__((ext_vector_type(2)));
typedef float f32x4 __attribute__((ext_vector_type(4)));
typedef float f32x16 __attribute__((ext_vector_type(16)));
typedef unsigned u32x2 __attribute__((ext_vector_type(2)));
typedef unsigned u32x4 __attribute__((ext_vector_type(4)));
typedef int v8i32 __attribute__((ext_vector_type(8)));
typedef int i32x4 __attribute__((ext_vector_type(4)));
typedef __bf16 bf16x2_t __attribute__((ext_vector_type(2)));

constexpr int DM = 2048, NTOK = 16384, SEQ = 2048, INC = 10240, NEXP = 32, DE = 512;
constexpr int PROWS = 40960;
constexpr float EPS = 1e-6f;
constexpr float LOG2E = 1.4426950408889634f;
constexpr float C_SB = LOG2E * 0.08838834764831845f;
constexpr float C_DA = LOG2E * 0.125f;

DI unsigned cvtpk(float lo, float hi) { f32x2 v = {lo, hi}; bf16x2_t b = __builtin_convertvector(v, bf16x2_t); return __builtin_bit_cast(unsigned, b); }
DI unsigned pk4_fp8(float a, float b, float c, float d) { int w = 0; w = __builtin_amdgcn_cvt_pk_fp8_f32(a, b, w, false); w = __builtin_amdgcn_cvt_pk_fp8_f32(c, d, w, true); return (unsigned)w; }
DI float sat8(float v) { return __builtin_amdgcn_fmed3f(v, -448.f, 448.f); }
DI unsigned pk4_fp8_sat(float a, float b, float c, float d) { return pk4_fp8(sat8(a), sat8(b), sat8(c), sat8(d)); }
DI float bf2f(unsigned short b) { return __builtin_bit_cast(float, (unsigned)b << 16); }
DI float bflo(unsigned w) { return __builtin_bit_cast(float, w << 16); }
DI float bfhi(unsigned w) { return __builtin_bit_cast(float, w & 0xffff0000u); }
DI float fexp2(float x) { return __builtin_amdgcn_exp2f(x); }
DI float flog2(float x) { return __builtin_amdgcn_logf(x); }
DI float frcp(float x) { return __builtin_amdgcn_rcpf(x); }
template <int X> DI float swzx(float v) { return __uint_as_float((unsigned)__builtin_amdgcn_ds_swizzle((int)__float_as_uint(v), (X << 10) | 0x1F)); }
DI float half_swap_sum(float v) { auto rr = __builtin_amdgcn_permlane32_swap(__float_as_uint(v), __float_as_uint(v), false, false); return __uint_as_float(rr[0]) + __uint_as_float(rr[1]); }
DI float wave_sum(float v) { v += swzx<1>(v); v += swzx<2>(v); v += swzx<4>(v); v += swzx<8>(v); v += swzx<16>(v); return half_swap_sum(v); }

namespace pg8 {
constexpr int BM = 256, BK = 64, HALF = 128, HTB = HALF * BK * 2, STAGE_BYTES = 8 * HTB, NXCD = 8, WGM = 8;
__host__ __device__ __forceinline__ int lds_byte(int r, int c) { const int c8 = c >> 3; return (r >> 3) * 1024 + (r & 7) * 128 + ((c8 ^ (r & 7)) << 4) + (c & 7) * 2; }
__host__ __device__ __forceinline__ void stage_rc(int b, int& R, int& C) { const int blk = b >> 10, w = (b & 1023) >> 4, r8 = w >> 3, c8 = (w & 7) ^ r8; R = blk * 8 + r8; C = c8 * 8 + (b & 15) / 2; }
__host__ __device__ __forceinline__ int perm32(int rho) { const int n = rho >> 4, i = rho & 15; return 8 * (i >> 2) + 4 * n + (i & 3); }

struct Unit { int pm, pn, bt; };
struct Gemm { const bf16_t* A; const bf16_t* Bt; int M, N, K; };

struct StaticOrder {
    int nM, nN, nwg, G, c;
    __host__ __device__ void init(int M, int N, int G_, int c_) { nM = M / BM; nN = N / BM; nwg = nM * nN; G = G_; c = c_; }
    __host__ __device__ bool next(int i, Unit& u) const {
        const long L = (long)i * G + c; if (L >= nwg) return false;
        int wgid = (int)L; { const int q = nwg / NXCD, r = nwg % NXCD, xcd = wgid % NXCD, off = wgid / NXCD; wgid = (xcd < r ? xcd * (q + 1) : r * (q + 1) + (xcd - r) * q) + off; }
        const int nig = WGM * nN, gid = wgid / nig, fm = gid * WGM, gsz = (nM - fm) < WGM ? (nM - fm) : WGM;
        u.pm = fm + ((wgid % nig) % gsz); u.pn = (wgid % nig) / gsz; u.bt = u.pn; return true;
    }
};
struct MoeOrder {
    const LAS int* tstart; int npn, G, c;
    DI bool next(int i, Unit& u) const {
        const int T = tstart[32], x = c & 7, lo = (T * x) >> 3, hi = (T * (x + 1)) >> 3;
        const int j = i * (G >> 3) + (c >> 3);
        const bool ok = j < (hi - lo) * npn;
        int tile = ok ? lo + j / npn : 0, pn = ok ? j % npn : 0, e = 0;
#pragma unroll
        for (int k = 1; k < 32; ++k) e += (tstart[k] <= tile) ? 1 : 0;
        u.pm = __builtin_amdgcn_readfirstlane(tile); u.pn = __builtin_amdgcn_readfirstlane(pn); u.bt = __builtin_amdgcn_readfirstlane(e * npn + pn);
        return __builtin_amdgcn_readfirstlane((int)ok) != 0;
    }
};

template <class Epi, class Sched, bool ALIGN_EPI, bool SP2>
DI void gemm_phase(LAS unsigned char* lds, const Gemm g, const Sched& S, const Epi& E) {
    int tid = threadIdx.x; asm volatile("" : "+v"(tid));
    const int wid = __builtin_amdgcn_readfirstlane(tid >> 6), lane = tid & 63, wr = wid >> 2, wc = wid & 3, fr = lane & 15, fq = lane >> 4;
    const int K = g.K, nt = K / BK;
    unsigned voffA[2], voffB[2];
#pragma unroll
    for (int i = 0; i < 2; ++i) { int R, C; stage_rc(tid * 16 + i * 8192, R, C); const int Rb = Epi::PERM ? ((R & ~31) + perm32(R & 31)) : R;
        voffA[i] = (unsigned)(R * K + C) * 2u; voffB[i] = (unsigned)(Rb * K + C) * 2u; }
    const size_t kstep = (size_t)(BK * 2);
    const size_t hstep = (size_t)HALF * K * 2;
    const size_t tstep = 2 * hstep;
    const unsigned ldsw = (unsigned)wid * 1024u;
    const int aoff = lds_byte(wr * 64 + fr, fq * 8), boff = lds_byte(wc * 32 + fr, fq * 8), aoff1 = aoff ^ 64, boff1 = boff ^ 64;
#define PG8_SA(b, h) (((b) * 2 + (h)) * HTB)
#define PG8_SB(b, h) ((4 + (b) * 2 + (h)) * HTB)
#define PG8_STAGE(bufoff, gbase, voff) do { _Pragma("unroll") for (int _i = 0; _i < 2; ++_i) \
        __builtin_amdgcn_global_load_lds((const unsigned*)((const char*)(gbase) + (voff)[_i]), (LAS unsigned*)(lds + (bufoff) + ldsw + _i * 8192), 16, 0, 0); } while (0)
#define PG8_LDA(dst, b, h) do { _Pragma("unroll") for (int m = 0; m < 4; ++m) _Pragma("unroll") for (int k = 0; k < 2; ++k) dst[m][k] = *(const LAS bf16x8*)(lds + PG8_SA(b, h) + (k ? aoff1 : aoff) + m * 2048); } while (0)
#define PG8_LDB(dst, b, h) do { _Pragma("unroll") for (int n = 0; n < 2; ++n) _Pragma("unroll") for (int k = 0; k < 2; ++k) dst[n][k] = *(const LAS bf16x8*)(lds + PG8_SB(b, h) + (k ? boff1 : boff) + n * 2048); } while (0)
#define PG8_MMA(ai, bj, At, Bt) do { __builtin_amdgcn_s_setprio(1); _Pragma("unroll") for (int m = 0; m < 4; ++m) _Pragma("unroll") for (int n = 0; n < 2; ++n) _Pragma("unroll") for (int k = 0; k < 2; ++k) \
        acc[ai][bj][m][n] = __builtin_amdgcn_mfma_f32_16x16x32_bf16(Bt[n][k], At[m][k], acc[ai][bj][m][n], 0, 0, 0); __builtin_amdgcn_s_setprio(0); } while (0)
#define PG8_WAIT_V(n) asm volatile("s_waitcnt vmcnt(" #n ")" ::: "memory")
#define PG8_WAIT_L(n) asm volatile("s_waitcnt lgkmcnt(" #n ")" ::: "memory")
#define PG8_BAR __builtin_amdgcn_s_barrier()
#define PG8_SCHED __builtin_amdgcn_sched_barrier(0)
    Unit cur, nxt; int ui = 0;
    if (!S.next(0, cur)) return;
    f32x4 acc[2][2][4][2];
#pragma unroll
    for (int a = 0; a < 2; ++a)
#pragma unroll
        for (int b = 0; b < 2; ++b)
#pragma unroll
            for (int m = 0; m < 4; ++m)
#pragma unroll
                for (int n = 0; n < 2; ++n) acc[a][b][m][n] = (f32x4){0.f, 0.f, 0.f, 0.f};
    bf16x8 At[4][2], B0[2][2], B1[2][2];
    const char* cA = (const char*)g.A + (size_t)cur.pm * tstep; const char* cB = (const char*)g.Bt + (size_t)cur.bt * tstep;
    if constexpr (SP2) {
        PG8_STAGE(PG8_SB(0, 0), cB, voffB); PG8_STAGE(PG8_SB(0, 1), cB + hstep, voffB); PG8_STAGE(PG8_SA(0, 0), cA, voffA); PG8_STAGE(PG8_SA(0, 1), cA + hstep, voffA);
        if (wr == 1) PG8_BAR;
        PG8_WAIT_V(2); PG8_BAR;
        PG8_STAGE(PG8_SB(1, 0), cB + kstep, voffB); PG8_STAGE(PG8_SA(1, 0), cA + kstep, voffA); PG8_STAGE(PG8_SB(1, 1), cB + hstep + kstep, voffB);
        PG8_WAIT_V(6); PG8_BAR;
    } else {
        PG8_STAGE(PG8_SB(0, 0), cB, voffB); PG8_STAGE(PG8_SA(0, 0), cA, voffA); PG8_STAGE(PG8_SB(0, 1), cB + hstep, voffB); PG8_STAGE(PG8_SA(0, 1), cA + hstep, voffA);
        if (wr == 1) PG8_BAR;
        PG8_WAIT_V(4); PG8_BAR;
        PG8_STAGE(PG8_SB(1, 0), cB + kstep, voffB); PG8_STAGE(PG8_SA(1, 0), cA + kstep, voffA); PG8_STAGE(PG8_SB(1, 1), cB + hstep + kstep, voffB);
        PG8_WAIT_V(6); PG8_BAR;
    }
    for (;;) {
        const bool has_next = S.next(ui + 1, nxt);
        const char* nA = has_next ? (const char*)g.A + (size_t)nxt.pm * tstep : cA; const char* nB = has_next ? (const char*)g.Bt + (size_t)nxt.bt * tstep : cB;
        for (int t = 0; t < nt; t += 2) {
            const bool last = (t == nt - 2);
            const char* a1 = cA + (size_t)(t + 1) * kstep;
            const char* a2 = last ? nA : cA + (size_t)(t + 2) * kstep; const char* b2 = last ? nB : cB + (size_t)(t + 2) * kstep;
            const char* a3 = a2 + kstep; const char* b3 = b2 + kstep;
            if constexpr (Epi::HAS_MID) { if (t == Epi::MID_T) E.mid(acc, cur, wr, wc, fr, fq); }
            if constexpr (SP2) {
            PG8_LDB(B0, 0, 0); PG8_LDB(B1, 0, 1); PG8_SCHED; PG8_LDA(At, 0, 0); PG8_STAGE(PG8_SA(1, 1), a1 + hstep, voffA);
            PG8_WAIT_V(8); PG8_WAIT_L(0); PG8_BAR; PG8_MMA(0, 0, At, B0); PG8_MMA(0, 1, At, B1); PG8_BAR; PG8_SCHED;
            PG8_LDA(At, 0, 1); PG8_STAGE(PG8_SB(0, 0), b2, voffB); PG8_STAGE(PG8_SB(0, 1), b2 + hstep, voffB); PG8_STAGE(PG8_SA(0, 0), a2, voffA);
            PG8_WAIT_V(8); PG8_WAIT_L(0); PG8_BAR; PG8_MMA(1, 0, At, B0); PG8_MMA(1, 1, At, B1); PG8_BAR; PG8_SCHED;
            PG8_LDB(B0, 1, 0); PG8_LDB(B1, 1, 1); PG8_SCHED; PG8_LDA(At, 1, 0); PG8_STAGE(PG8_SA(0, 1), a2 + hstep, voffA);
            PG8_WAIT_V(8); PG8_WAIT_L(0); PG8_BAR; PG8_MMA(0, 0, At, B0); PG8_MMA(0, 1, At, B1); PG8_BAR; PG8_SCHED;
            PG8_LDA(At, 1, 1); PG8_STAGE(PG8_SB(1, 0), b3, voffB); PG8_STAGE(PG8_SB(1, 1), b3 + hstep, voffB); PG8_STAGE(PG8_SA(1, 0), a3, voffA);
            PG8_WAIT_V(8); PG8_WAIT_L(0); PG8_BAR; PG8_MMA(1, 0, At, B0); PG8_MMA(1, 1, At, B1); PG8_BAR; PG8_SCHED;
            } else {
            PG8_LDB(B0, 0, 0); PG8_SCHED; PG8_LDA(At, 0, 0); PG8_STAGE(PG8_SA(1, 1), a1 + hstep, voffA);
            PG8_WAIT_L(8); PG8_BAR; PG8_WAIT_L(0); PG8_MMA(0, 0, At, B0); PG8_BAR; PG8_SCHED;
            PG8_LDB(B1, 0, 1); PG8_STAGE(PG8_SB(0, 0), b2, voffB);
            PG8_BAR; PG8_WAIT_L(0); PG8_MMA(0, 1, At, B1); PG8_BAR;
            PG8_LDA(At, 0, 1); PG8_STAGE(PG8_SA(0, 0), a2, voffA);
            PG8_BAR; PG8_WAIT_L(0); PG8_MMA(1, 0, At, B0); PG8_BAR; PG8_SCHED;
            PG8_STAGE(PG8_SB(0, 1), b2 + hstep, voffB);
            PG8_WAIT_V(6); PG8_BAR; PG8_MMA(1, 1, At, B1); PG8_BAR;
            PG8_LDB(B0, 1, 0); PG8_SCHED; PG8_LDA(At, 1, 0); PG8_STAGE(PG8_SA(0, 1), a2 + hstep, voffA);
            PG8_WAIT_L(8); PG8_BAR; PG8_WAIT_L(0); PG8_MMA(0, 0, At, B0); PG8_BAR; PG8_SCHED;
            PG8_LDB(B1, 1, 1); PG8_STAGE(PG8_SB(1, 0), b3, voffB);
            PG8_BAR; PG8_WAIT_L(0); PG8_MMA(0, 1, At, B1); PG8_BAR;
            PG8_LDA(At, 1, 1); PG8_STAGE(PG8_SA(1, 0), a3, voffA);
            PG8_BAR; PG8_WAIT_L(0); PG8_MMA(1, 0, At, B0); PG8_BAR; PG8_SCHED;
            PG8_STAGE(PG8_SB(1, 1), b3 + hstep, voffB);
            PG8_WAIT_V(6); PG8_BAR; PG8_MMA(1, 1, At, B1); PG8_BAR;
            }
        }
        if constexpr (ALIGN_EPI) { if (wr == 0) PG8_BAR; }
        E(acc, cur, wr, wc, fr, fq);
        if (!has_next) break;
#pragma unroll
        for (int a = 0; a < 2; ++a)
#pragma unroll
            for (int b = 0; b < 2; ++b)
#pragma unroll
                for (int m = 0; m < 4; ++m)
#pragma unroll
                    for (int n = 0; n < 2; ++n) acc[a][b][m][n] = (f32x4){0.f, 0.f, 0.f, 0.f};
        cur = nxt; cA = nA; cB = nB; ++ui;
        if constexpr (ALIGN_EPI) { if (wr == 1) PG8_BAR; }
    }
    PG8_WAIT_V(0);
    if constexpr (!ALIGN_EPI) { if (wr == 0) PG8_BAR; }
    PG8_BAR;
#undef PG8_SA
#undef PG8_SB
#undef PG8_STAGE
#undef PG8_LDA
#undef PG8_LDB
#undef PG8_MMA
#undef PG8_WAIT_V
#undef PG8_WAIT_L
#undef PG8_BAR
#undef PG8_SCHED
}

typedef f32x4 AccN[2][4][2];
template <class Epi, class Sched, int SCW, int SCX>
DI void gemm_f8_phase(LAS unsigned char* lds, const Gemm g, const Sched& S, const Epi& E) {
    int tid = threadIdx.x; asm volatile("" : "+v"(tid));
    const int wid = __builtin_amdgcn_readfirstlane(tid >> 6), lane = tid & 63, wr = wid >> 2, wc = wid & 3, fr = lane & 15, fq = lane >> 4;
    const int K = g.K, nt = K / BK;
    unsigned voffA[2], voffB[2];
#pragma unroll
    for (int i = 0; i < 2; ++i) { int R, C; stage_rc(tid * 16 + i * 8192, R, C); const int Rb = (R & ~31) + perm32(R & 31);
        voffA[i] = (unsigned)(R * K + C) * 2u; voffB[i] = (unsigned)(Rb * K + C) * 2u; }
    const size_t kstep = (size_t)(BK * 2);
    const size_t hstep = (size_t)HALF * K * 2;
    const size_t tstep = 2 * hstep;
    const unsigned ldsw = (unsigned)wid * 1024u;
    const int aoff = lds_byte(wr * 64 + fr, fq * 8), boff = lds_byte(wc * 32 + fr, fq * 8), aoff1 = aoff ^ 64, boff1 = boff ^ 64;
    const int scw = SCW * 0x01010101, scx = SCX * 0x01010101;
#define PG8_SA(b, h) (((b) * 2 + (h)) * HTB)
#define PG8_SB(b, h) ((4 + (b) * 2 + (h)) * HTB)
#define PG8_STAGE(bufoff, gbase, voff) do { _Pragma("unroll") for (int _i = 0; _i < 2; ++_i) \
        __builtin_amdgcn_global_load_lds((const unsigned*)((const char*)(gbase) + (voff)[_i]), (LAS unsigned*)(lds + (bufoff) + ldsw + _i * 8192), 16, 0, 0); } while (0)
#define PG8_LD16(off) (*(const LAS i32x4*)(lds + (off)))
#define PG8_LDA8(dst, b, h) do { _Pragma("unroll") for (int m = 0; m < 4; ++m) dst[m] = __builtin_shufflevector(PG8_LD16(PG8_SA(b, h) + aoff + m * 2048), PG8_LD16(PG8_SA(b, h) + aoff1 + m * 2048), 0, 1, 2, 3, 4, 5, 6, 7); } while (0)
#define PG8_LDB8(dst, b) do { _Pragma("unroll") for (int n = 0; n < 2; ++n) dst[n] = __builtin_shufflevector(PG8_LD16(PG8_SB(b, 0) + boff + n * 2048), PG8_LD16(PG8_SB(b, 0) + boff1 + n * 2048), 0, 1, 2, 3, 4, 5, 6, 7); } while (0)
#define PG8_MMA8(ai) do { __builtin_amdgcn_s_setprio(1); _Pragma("unroll") for (int m = 0; m < 4; ++m) _Pragma("unroll") for (int n = 0; n < 2; ++n) \
        acc[ai][m][n] = __builtin_amdgcn_mfma_scale_f32_16x16x128_f8f6f4(B08[n], At8[m], acc[ai][m][n], 0, 0, 0, scw, 0, scx); __builtin_amdgcn_s_setprio(0); } while (0)
#define PG8_WAIT_V(n) asm volatile("s_waitcnt vmcnt(" #n ")" ::: "memory")
#define PG8_WAIT_L(n) asm volatile("s_waitcnt lgkmcnt(" #n ")" ::: "memory")
#define PG8_BAR __builtin_amdgcn_s_barrier()
#define PG8_SCHED __builtin_amdgcn_sched_barrier(0)
    Unit cur, nxt; int ui = 0;
    if (!S.next(0, cur)) return;
    f32x4 acc[2][4][2];
#pragma unroll
    for (int a = 0; a < 2; ++a)
#pragma unroll
        for (int m = 0; m < 4; ++m)
#pragma unroll
            for (int n = 0; n < 2; ++n) acc[a][m][n] = (f32x4){0.f, 0.f, 0.f, 0.f};
    v8i32 At8[4], B08[2];
    const char* cA = (const char*)g.A + (size_t)cur.pm * tstep; const char* cB = (const char*)g.Bt + (size_t)cur.bt * hstep;
    PG8_STAGE(PG8_SB(0, 0), cB, voffB); PG8_STAGE(PG8_SA(0, 0), cA, voffA); PG8_STAGE(PG8_SA(0, 1), cA + hstep, voffA);
    if (wr == 1) PG8_BAR;
    PG8_WAIT_V(2); PG8_BAR;
    PG8_STAGE(PG8_SB(1, 0), cB + kstep, voffB); PG8_STAGE(PG8_SA(1, 0), cA + kstep, voffA);
    PG8_WAIT_V(4); PG8_BAR;
    for (;;) {
        const bool has_next = S.next(ui + 1, nxt);
        const char* nA = has_next ? (const char*)g.A + (size_t)nxt.pm * tstep : cA; const char* nB = has_next ? (const char*)g.Bt + (size_t)nxt.bt * hstep : cB;
#pragma unroll 1
        for (int t = 0; t < nt; t += 2) {
            const bool last = (t == nt - 2);
            const char* a1 = cA + (size_t)(t + 1) * kstep;
            const char* a2 = last ? nA : cA + (size_t)(t + 2) * kstep; const char* b2 = last ? nB : cB + (size_t)(t + 2) * kstep;
            const char* a3 = a2 + kstep; const char* b3 = b2 + kstep;
            PG8_LDB8(B08, 0); PG8_SCHED; PG8_LDA8(At8, 0, 0); PG8_STAGE(PG8_SA(1, 1), a1 + hstep, voffA);
            PG8_WAIT_V(6); PG8_WAIT_L(0); PG8_BAR; PG8_MMA8(0); PG8_BAR; PG8_SCHED;
            PG8_LDA8(At8, 0, 1); PG8_STAGE(PG8_SB(0, 0), b2, voffB); PG8_STAGE(PG8_SA(0, 0), a2, voffA);
            PG8_WAIT_V(6); PG8_WAIT_L(0); PG8_BAR; PG8_MMA8(1); PG8_BAR; PG8_SCHED;
            PG8_LDB8(B08, 1); PG8_SCHED; PG8_LDA8(At8, 1, 0); PG8_STAGE(PG8_SA(0, 1), a2 + hstep, voffA);
            PG8_WAIT_V(6); PG8_WAIT_L(0); PG8_BAR; PG8_MMA8(0); PG8_BAR; PG8_SCHED;
            PG8_LDA8(At8, 1, 1); PG8_STAGE(PG8_SB(1, 0), b3, voffB); PG8_STAGE(PG8_SA(1, 0), a3, voffA);
            PG8_WAIT_V(6); PG8_WAIT_L(0); PG8_BAR; PG8_MMA8(1); PG8_BAR; PG8_SCHED;
        }
        if (wr == 0) PG8_BAR;
        E(acc, cur, wr, wc, fr, fq);
        if (!has_next) break;
#pragma unroll
        for (int a = 0; a < 2; ++a)
#pragma unroll
            for (int m = 0; m < 4; ++m)
#pragma unroll
                for (int n = 0; n < 2; ++n) acc[a][m][n] = (f32x4){0.f, 0.f, 0.f, 0.f};
        cur = nxt; cA = nA; cB = nB; ++ui;
        if (wr == 1) PG8_BAR;
    }
    PG8_WAIT_V(0);
    PG8_BAR;
#undef PG8_SA
#undef PG8_SB
#undef PG8_STAGE
#undef PG8_LD16
#undef PG8_LDA8
#undef PG8_LDB8
#undef PG8_MMA8
#undef PG8_WAIT_V
#undef PG8_WAIT_L
#undef PG8_BAR
#undef PG8_SCHED
}

typedef f32x4 AccQ[4][4];
template <class Epi, class Sched, int SCW, int SCX, int FMT = 0  >
DI void gemm_f8v2_phase(LAS unsigned char* lds, const Gemm g, const Sched& S, const Epi& E) {
    int tid = threadIdx.x; asm volatile("" : "+v"(tid));
    const int wid = __builtin_amdgcn_readfirstlane(tid >> 6), lane = tid & 63, wr4 = wid >> 1, wc2 = wid & 1, fr = lane & 15, fq = lane >> 4;
    const int K = g.K, nt = K / BK;
    unsigned voffA[2], voffB[2];
#pragma unroll
    for (int i = 0; i < 2; ++i) { int R, C; stage_rc(tid * 16 + i * 8192, R, C); const int Rb = (R & ~31) + perm32(R & 31);
        voffA[i] = (unsigned)(R * K + C) * 2u; voffB[i] = (unsigned)(Rb * K + C) * 2u; }
    const size_t kstep = (size_t)(BK * 2);
    const size_t hstep = (size_t)HALF * K * 2;
    const size_t tstep = 2 * hstep;
    const unsigned ldsw = (unsigned)wid * 1024u;
    constexpr int BUFB = 3 * HTB;
    const int aoff = (wr4 >> 1) * HTB + lds_byte((wr4 & 1) * 64 + fr, fq * 8), boff = 2 * HTB + lds_byte(wc2 * 64 + fr, fq * 8);
    const int scw = SCW * 0x01010101, scx = SCX * 0x01010101;
#define F8_STAGE(ldsoff, gbase, voff) do { _Pragma("unroll") for (int _i = 0; _i < 2; ++_i) \
        __builtin_amdgcn_global_load_lds((const unsigned*)((const char*)(gbase) + (voff)[_i]), (LAS unsigned*)(lds + (ldsoff) + ldsw + _i * 8192), 16, 0, 0); } while (0)
#define F8_STAGE3(bufoff, pa, pb) do { F8_STAGE((bufoff), (pa), voffA); F8_STAGE((bufoff) + HTB, (pa) + hstep, voffA); F8_STAGE((bufoff) + 2 * HTB, (pb), voffB); } while (0)
#define F8_LD16(off) (*(const LAS i32x4*)(lds + (off)))
#define F8_LDF(dst, base, k) dst = __builtin_shufflevector(F8_LD16((base) + (k) * 2048), F8_LD16(((base) ^ 64) + (k) * 2048), 0, 1, 2, 3, 4, 5, 6, 7)
#define F8_MMA(CA, CB, m, q) acc[m][q] = __builtin_amdgcn_mfma_scale_f32_16x16x128_f8f6f4(CB[q], CA[m], acc[m][q], FMT, FMT, 0, scw, 0, scx)
#define F8_WAIT_V(n) asm volatile("s_waitcnt vmcnt(" #n ")" ::: "memory")
#define F8_WAIT_L(n) asm volatile("s_waitcnt lgkmcnt(" #n ")" ::: "memory")
#define F8_SCHED __builtin_amdgcn_sched_barrier(0)
#define F8_PIN(m) asm volatile("" : "+v"(acc[m][0]), "+v"(acc[m][1]), "+v"(acc[m][2]), "+v"(acc[m][3]))
#define F8_PIECE(ldsoff, gbase, voff, i) __builtin_amdgcn_global_load_lds((const unsigned*)((const char*)(gbase) + (voff)[i]), (LAS unsigned*)(lds + (ldsoff) + ldsw + (i) * 8192), 16, 0, 0)
#define F8_TILE(CA, CB, NA, NB) do { \
        F8_WAIT_L(0); F8_SCHED; __builtin_amdgcn_s_setprio(1); \
          \
        F8_MMA(CA, CB, 0, 0); F8_MMA(CA, CB, 0, 1); F8_MMA(CA, CB, 0, 2); F8_MMA(CA, CB, 0, 3); F8_SCHED; \
        F8_WAIT_V(6); __builtin_amdgcn_s_barrier(); \
        { const bool w_ = (dt == nt); dA = w_ ? nA : dA; dB = w_ ? nB : dB; dt = w_ ? 0 : dt; } \
        { const int db_ = bufc * BUFB; bufc = (bufc == 2) ? 0 : bufc + 1; const int ra_ = aoff + bufc * BUFB, rb_ = boff + bufc * BUFB; F8_SCHED; \
            \
          F8_MMA(CA, CB, 1, 0); F8_MMA(CA, CB, 1, 1); F8_LDF(NB[0], rb_, 0); F8_LDF(NA[0], ra_, 0); F8_SCHED; F8_MMA(CA, CB, 1, 2); F8_MMA(CA, CB, 1, 3); F8_LDF(NB[1], rb_, 1); F8_LDF(NB[2], rb_, 2); F8_SCHED; \
          F8_MMA(CA, CB, 2, 0); F8_MMA(CA, CB, 2, 1); F8_LDF(NB[3], rb_, 3); F8_LDF(NA[1], ra_, 1); F8_PIECE(db_, dA, voffA, 0); F8_SCHED; F8_MMA(CA, CB, 2, 2); F8_MMA(CA, CB, 2, 3); F8_LDF(NA[2], ra_, 2); F8_LDF(NA[3], ra_, 3); F8_PIECE(db_, dA, voffA, 1); F8_SCHED; \
          F8_MMA(CA, CB, 3, 0); F8_MMA(CA, CB, 3, 1); F8_PIECE(db_ + HTB, dA + hstep, voffA, 0); F8_PIECE(db_ + HTB, dA + hstep, voffA, 1); F8_SCHED; F8_MMA(CA, CB, 3, 2); F8_MMA(CA, CB, 3, 3); F8_PIECE(db_ + 2 * HTB, dB, voffB, 0); F8_PIECE(db_ + 2 * HTB, dB, voffB, 1); F8_SCHED; \
          __builtin_amdgcn_s_setprio(0); F8_PIN(0); F8_PIN(1); F8_PIN(2); F8_PIN(3); } \
        dA += kstep; dB += kstep; ++dt; \
    } while (0)
    Unit cur, nxt; int ui = 0;
    if (!S.next(0, cur)) return;
    f32x4 acc[4][4];
#pragma unroll
    for (int m = 0; m < 4; ++m)
#pragma unroll
        for (int q = 0; q < 4; ++q) acc[m][q] = (f32x4){0.f, 0.f, 0.f, 0.f};
    v8i32 A0[4], B0[4], A1[4], B1[4];
    const char* cA = (const char*)g.A + (size_t)cur.pm * tstep; const char* cB = (const char*)g.Bt + (size_t)cur.bt * hstep;
    int bufc = 0, dt = 3;
    F8_STAGE3(0, cA, cB); F8_STAGE3(BUFB, cA + kstep, cB + kstep); F8_STAGE3(2 * BUFB, cA + 2 * kstep, cB + 2 * kstep);
    const char* dA = cA + 3 * kstep; const char* dB = cB + 3 * kstep;
    F8_WAIT_V(12); __builtin_amdgcn_s_barrier();
#pragma unroll
    for (int k = 0; k < 4; ++k) { F8_LDF(B0[k], boff, k); F8_LDF(A0[k], aoff, k); }
    for (;;) {
        const bool has_next = S.next(ui + 1, nxt);
        const char* nA = has_next ? (const char*)g.A + (size_t)nxt.pm * tstep : cA; const char* nB = has_next ? (const char*)g.Bt + (size_t)nxt.bt * hstep : cB;
#pragma unroll 1
        for (int t = 0; t < nt; t += 2) {
            F8_TILE(A0, B0, A1, B1);
            F8_TILE(A1, B1, A0, B0);
        }
        E(acc, cur, wr4, wc2, fr, fq);
        if (!has_next) break;
#pragma unroll
        for (int m = 0; m < 4; ++m)
#pragma unroll
            for (int q = 0; q < 4; ++q) acc[m][q] = (f32x4){0.f, 0.f, 0.f, 0.f};
        cur = nxt; cA = nA; cB = nB; ++ui;
    }
    F8_WAIT_V(0); F8_WAIT_L(0);
    __builtin_amdgcn_s_barrier();
#undef F8_STAGE
#undef F8_STAGE3
#undef F8_LD16
#undef F8_LDF
#undef F8_MMA
#undef F8_WAIT_V
#undef F8_WAIT_L
#undef F8_SCHED
#undef F8_TILE
#undef F8_PIECE
#undef F8_PIN
}

typedef f32x4 Acc[2][2][4][2];
DI u32x4 pack8(const f32x4 a, const f32x4 b) { u32x4 w; w.x = cvtpk(a[0], a[1]); w.y = cvtpk(a[2], a[3]); w.z = cvtpk(b[0], b[1]); w.w = cvtpk(b[2], b[3]); return w; }

struct EpiInProj {
    static constexpr bool PERM = true, HAS_MID = false; static constexpr int MID_T = 0;
    bf16_t* qkv;
    const f32x2* rope;
    DI void mid(Acc&, const Unit&, int, int, int, int) const {}
    DI void operator()(Acc& acc, const Unit& u, int wr, int wc, int fr, int fq) const {
 asm volatile("" : "+v"(fr), "+v"(fq));
               const int pn = u.pn, row0 = u.pm * BM + wr * 64 + fr;
        if (pn >= 12 && pn < 20) {
            const int tsel = (pn < 16) ? 3 : 4; const float sc = (pn < 16) ? C_DA : 1.f;
            bf16_t* dst = qkv + (size_t)tsel * NTOK * 1024; const int col0 = ((pn - 12) & 3) * 256 + wc * 64 + 8 * fq;
            f32x4 st[4], cs0[4], cs1[4];
            { const f32x4* sp = (const f32x4*)(rope + (size_t)16 * 32 + 8 * fq); const f32x4* p0 = (const f32x4*)(rope + (size_t)(row0 & (SEQ - 1)) * 32 + 8 * fq);
              const f32x4* p1 = (const f32x4*)(rope + (size_t)((row0 + HALF) & (SEQ - 1)) * 32 + 8 * fq);
#pragma unroll
              for (int k = 0; k < 4; ++k) { st[k] = sp[k]; cs0[k] = p0[k]; cs1[k] = p1[k]; } }
#pragma unroll
            for (int ai = 0; ai < 2; ++ai) { f32x4 cs[4];
#pragma unroll
                for (int k = 0; k < 4; ++k) cs[k] = ai ? cs1[k] : cs0[k];
#pragma unroll
                for (int m = 0; m < 4; ++m) {
                    if (m > 0) {
#pragma unroll
                        for (int k = 0; k < 4; ++k) { const f32x4 c = cs[k], d = st[k];
                            cs[k] = (f32x4){c[0] * d[0] - c[1] * d[1], c[1] * d[0] + c[0] * d[1], c[2] * d[2] - c[3] * d[3], c[3] * d[2] + c[2] * d[3]}; } }
#pragma unroll
                    for (int n = 0; n < 2; ++n) { const f32x4 c0 = cs[2 * n], c1 = cs[2 * n + 1]; const f32x4 xl = acc[ai][0][m][n], xh = acc[ai][1][m][n];
                        const float co[4] = {c0[0], c0[2], c1[0], c1[2]}, si[4] = {c0[1], c0[3], c1[1], c1[3]};
#pragma unroll
                        for (int j = 0; j < 4; ++j) { acc[ai][0][m][n][j] = (xl[j] * co[j] - xh[j] * si[j]) * sc; acc[ai][1][m][n][j] = (xh[j] * co[j] + xl[j] * si[j]) * sc; } }
                    bf16_t* rowp = dst + (size_t)(row0 + ai * HALF + m * 16) * 1024 + col0;
                    __builtin_nontemporal_store(pack8(acc[ai][0][m][0], acc[ai][0][m][1]), (u32x4*)(rowp)); __builtin_nontemporal_store(pack8(acc[ai][1][m][0], acc[ai][1][m][1]), (u32x4*)(rowp + 32)); } }
        } else {
            const int tsel = (pn < 12) ? (pn >> 2) : 5; const float sc = (pn < 4) ? C_SB : 1.f;
            bf16_t* dst = qkv + (size_t)tsel * NTOK * 1024; const int col0 = (pn & 3) * 256 + wc * 32 + 8 * fq;
#pragma unroll
            for (int ai = 0; ai < 2; ++ai)
#pragma unroll
                for (int m = 0; m < 4; ++m) { bf16_t* rowp = dst + (size_t)(row0 + ai * HALF + m * 16) * 1024 + col0;
#pragma unroll
                    for (int bj = 0; bj < 2; ++bj) __builtin_nontemporal_store(pack8(acc[ai][bj][m][0] * sc, acc[ai][bj][m][1] * sc), (u32x4*)(rowp + bj * HALF)); }
        }
    }
};

struct EpiMerged {
    static constexpr bool PERM = true, HAS_MID = true; static constexpr int MID_T = 16;
    const bf16_t* gsb; const bf16_t* gda; bf16_t* merged;
    DI void mid(Acc& acc, const Unit& u, int wr, int wc, int fr, int fq) const {
        asm volatile("" : "+v"(fr), "+v"(fq));
        const int row0 = u.pm * BM + wr * 64 + fr, col0 = u.pn * BM + wc * 32 + 8 * fq;
        u32x4 a[2][4][2];
#pragma unroll
        for (int ai = 0; ai < 2; ++ai)
#pragma unroll
            for (int m = 0; m < 4; ++m) { const size_t off = (size_t)(row0 + ai * HALF + m * 16) * 2048 + col0;
#pragma unroll
                for (int bj = 0; bj < 2; ++bj) a[ai][m][bj] = *(const u32x4*)(gsb + off + bj * HALF); }
        asm volatile("" ::: "memory");
#pragma unroll
        for (int ai = 0; ai < 2; ++ai)
#pragma unroll
            for (int m = 0; m < 4; ++m)
#pragma unroll
                for (int bj = 0; bj < 2; ++bj)
#pragma unroll
                    for (int w = 0; w < 4; ++w) { acc[ai][bj][m][w >> 1][(w & 1) * 2] *= bflo(a[ai][m][bj][w]); acc[ai][bj][m][w >> 1][(w & 1) * 2 + 1] *= bfhi(a[ai][m][bj][w]); }
        asm volatile("" ::: "memory");
    }
    DI void operator()(Acc& acc, const Unit& u, int wr, int wc, int fr, int fq) const {
        asm volatile("" : "+v"(fr), "+v"(fq));
        const int row0 = u.pm * BM + wr * 64 + fr, col0 = u.pn * BM + wc * 32 + 8 * fq;
        u32x4 b[2][4][2];
#pragma unroll
        for (int ai = 0; ai < 2; ++ai)
#pragma unroll
            for (int m = 0; m < 4; ++m) { const size_t off = (size_t)(row0 + ai * HALF + m * 16) * 2048 + col0;
#pragma unroll
                for (int bj = 0; bj < 2; ++bj) b[ai][m][bj] = *(const u32x4*)(gda + off + bj * HALF); }
        asm volatile("" ::: "memory");
#pragma unroll
        for (int ai = 0; ai < 2; ++ai)
#pragma unroll
            for (int m = 0; m < 4; ++m) { const size_t off = (size_t)(row0 + ai * HALF + m * 16) * 2048 + col0;
#pragma unroll
                for (int bj = 0; bj < 2; ++bj) { const u32x4 g = b[ai][m][bj]; f32x4 v0 = acc[ai][bj][m][0], v1 = acc[ai][bj][m][1];
                    v0[0] *= bflo(g[0]); v0[1] *= bfhi(g[0]); v0[2] *= bflo(g[1]); v0[3] *= bfhi(g[1]); v1[0] *= bflo(g[2]); v1[1] *= bfhi(g[2]); v1[2] *= bflo(g[3]); v1[3] *= bfhi(g[3]);
                    *(u32x4*)(merged + off + bj * HALF) = pack8(v0, v1); } }
    }
};

struct EpiX1 {
    static constexpr bool PERM = true, HAS_MID = false; static constexpr int MID_T = 0;
    const float* x; bf16_t* x1b; float* ssq;
    DI void mid(Acc&, const Unit&, int, int, int, int) const {}
    DI void operator()(Acc& acc, const Unit& u, int wr, int wc, int fr, int fq) const {
        asm volatile("" : "+v"(fr), "+v"(fq));
        const int row0 = u.pm * BM + wr * 64 + fr, col0 = u.pn * BM + wc * 32 + 8 * fq;
        float sq[2][4];
#pragma unroll
        for (int ai = 0; ai < 2; ++ai) { f32x4 xv[4][2][2];
#pragma unroll
            for (int m = 0; m < 4; ++m) { const size_t off = (size_t)(row0 + ai * HALF + m * 16) * 2048 + col0;
#pragma unroll
                for (int bj = 0; bj < 2; ++bj) { xv[m][bj][0] = *(const f32x4*)(x + off + bj * HALF); xv[m][bj][1] = *(const f32x4*)(x + off + bj * HALF + 4); } }
            asm volatile("" ::: "memory");
#pragma unroll
            for (int m = 0; m < 4; ++m) { float s = 0.f;
#pragma unroll
                for (int bj = 0; bj < 2; ++bj) { const f32x4 v0 = acc[ai][bj][m][0] + xv[m][bj][0], v1 = acc[ai][bj][m][1] + xv[m][bj][1]; acc[ai][bj][m][0] = v0; acc[ai][bj][m][1] = v1;
                    s += (v0[0] * v0[0] + v0[1] * v0[1]) + (v0[2] * v0[2] + v0[3] * v0[3]) + (v1[0] * v1[0] + v1[1] * v1[1]) + (v1[2] * v1[2] + v1[3] * v1[3]); }
                s += swzx<16>(s); s = half_swap_sum(s); sq[ai][m] = s; }
            asm volatile("" ::: "memory"); }
#pragma unroll
        for (int ai = 0; ai < 2; ++ai)
#pragma unroll
            for (int m = 0; m < 4; ++m) { const int row = row0 + ai * HALF + m * 16; const size_t off = (size_t)row * 2048 + col0;
#pragma unroll
                for (int bj = 0; bj < 2; ++bj) *(u32x4*)(x1b + off + bj * HALF) = pack8(acc[ai][bj][m][0], acc[ai][bj][m][1]);
                if (fq == 0) ssq[(size_t)row * 32 + u.pn * 4 + wc] = sq[ai][m]; }
    }
};

struct EpiSwiglu2 {
    static constexpr int NST = 8;
    unsigned char* H;
    DI void operator()(AccQ& acc, const Unit& u, int wr4, int wc2, int fr, int fq) const {
        asm volatile("" : "+v"(fr), "+v"(fq));
        const int row0 = u.pm * BM + wr4 * 64 + fr, col0 = u.pn * 64 + wc2 * 32 + 4 * fq;
#pragma unroll
        for (int c2 = 0; c2 < 2; ++c2)
#pragma unroll
            for (int m = 0; m < 4; ++m) { float h[4];
#pragma unroll
                for (int j = 0; j < 4; ++j) { const float gt = acc[m][2 * c2][j], up = acc[m][2 * c2 + 1][j]; h[j] = gt * up * frcp(1.f + fexp2(-LOG2E * gt)); }
                *(unsigned*)(H + (size_t)(row0 + m * 16) * DE + col0 + 16 * c2) = pk4_fp8_sat(h[0], h[1], h[2], h[3]); }
    }
};
struct EpiGate2 {
    bf16_t* gsb; bf16_t* gda;
    DI void operator()(AccQ& acc, const Unit& u, int wr4, int wc2, int fr, int fq) const {
        asm volatile("" : "+v"(fr), "+v"(fq));
        const int row0 = u.pm * BM + wr4 * 64 + fr, col0 = u.pn * 64 + wc2 * 32 + 8 * fq;
#pragma unroll
        for (int m = 0; m < 4; ++m) { f32x4 r0, r1, d0, d1;
#pragma unroll
            for (int j = 0; j < 4; ++j) { const float ea0 = fexp2(-LOG2E * acc[m][0][j]), ea1 = fexp2(-LOG2E * acc[m][1][j]), eb0 = fexp2(-LOG2E * acc[m][2][j]), eb1 = fexp2(-LOG2E * acc[m][3][j]);
                r0[j] = (1.f + eb0) * frcp(1.f + ea0); r1[j] = (1.f + eb1) * frcp(1.f + ea1); d0[j] = frcp(1.f + eb0); d1[j] = frcp(1.f + eb1); }
            const size_t off = (size_t)(row0 + m * 16) * 2048 + col0;
            __builtin_nontemporal_store(pack8(r0, r1), (u32x4*)(gsb + off)); __builtin_nontemporal_store(pack8(d0, d1), (u32x4*)(gda + off)); }
    }
};
struct EpiDown2 {
    static constexpr int NST = 8;
    unsigned char* Y;
    DI void operator()(AccQ& acc, const Unit& u, int wr4, int wc2, int fr, int fq) const {
        asm volatile("" : "+v"(fr), "+v"(fq));
        const int row0 = u.pm * BM + wr4 * 64 + fr, col0 = u.pn * HALF + wc2 * 64 + 8 * fq;
#pragma unroll
        for (int c2 = 0; c2 < 2; ++c2)
#pragma unroll
            for (int m = 0; m < 4; ++m) { const f32x4 a = acc[m][2 * c2] * 32.f, b = acc[m][2 * c2 + 1] * 32.f; u32x2 w; w.x = pk4_fp8_sat(a[0], a[1], a[2], a[3]); w.y = pk4_fp8_sat(b[0], b[1], b[2], b[3]);
                *(u32x2*)(Y + (size_t)(row0 + m * 16) * 2048 + col0 + 32 * c2) = w; }
    }
};
}

namespace att {
#define MFMA32(a, b, c) __builtin_amdgcn_mfma_f32_32x32x16_bf16((a), (b), (c), 0, 0, 0)
#define SBAR() __builtin_amdgcn_sched_barrier(0)
#define WAIT_BAR() asm volatile("s_waitcnt vmcnt(0) lgkmcnt(0)\n\ts_barrier" ::: "memory")
DI int crow(int r, int h) { return (r & 3) + 8 * (r >> 2) + 4 * h; }
DI int img_off(int row, int ch) { return 256 * row + 16 * (ch ^ (((row & 3) << 2) | ((row >> 2) & 3))); }
constexpr int TKEYS = 128, L_BUF = 65536, L_V = 32768, L_STG = 0, L_WSF = 131072 + 2048, L_FLAG = 131072 + 1024;
typedef short v4i16_t __attribute__((ext_vector_type(4)));
DI s16x4 tr16(const LAS unsigned char* p) { return __builtin_bit_cast(s16x4, __builtin_amdgcn_ds_read_tr16_b64_v4i16((LAS v4i16_t*)p)); }
template <int X> DI float swz_xor(float v) { return __uint_as_float((unsigned)__builtin_amdgcn_ds_swizzle((int)__float_as_uint(v), (X << 10) | 0x1F)); }
DI float xhalf_sum(float v) { auto rr = __builtin_amdgcn_permlane32_swap(__float_as_uint(v), __float_as_uint(v), false, false); return __uint_as_float(rr[0]) + __uint_as_float(rr[1]); }
DI float max3f(float a, float b, float c) { return __builtin_elementwise_maximum(__builtin_elementwise_maximum(a, b), c); }
DI float xhalf_max(float v) { auto rr = __builtin_amdgcn_permlane32_swap(__float_as_uint(v), __float_as_uint(v), false, false); return fmaxf(__uint_as_float(rr[0]), __uint_as_float(rr[1])); }
DI void glds16(const void* gbase, unsigned voff, unsigned lds_dst) { unsigned keep;
    asm volatile("s_nop 4\n\ts_mov_b32 %0, m0\n\ts_mov_b32 m0, %3\n\ts_nop 0\n\tglobal_load_lds_dwordx4 %1, %2\n\ts_mov_b32 m0, %0" : "=&s"(keep) : "v"(voff), "s"(gbase), "s"(lds_dst) : "memory"); }
DI void tile_offs(unsigned (&voff)[4], int wid, int lane) {
#pragma unroll
    for (int i4 = 0; i4 < 4; ++i4) { const int pc = i4 * 8 + wid, row = pc * 4 + (lane >> 4), f = ((lane >> 4) << 2) | (pc & 3); voff[i4] = (unsigned)(row * 2048 + (((lane & 15) ^ f) * 16)); }
}
template <int I0 = 0, int I1 = 4> DI void tile_issue(const bf16_t* Kt, const bf16_t* Vt, const unsigned (&voff)[4], unsigned bufaddr, int wid) {
#pragma unroll
    for (int i4 = I0; i4 < I1; ++i4) { const int pc = i4 * 8 + wid;
        glds16(Kt, voff[i4], (unsigned)__builtin_amdgcn_readfirstlane((int)(bufaddr + pc * 1024)));
        glds16(Vt, voff[i4], (unsigned)__builtin_amdgcn_readfirstlane((int)(bufaddr + L_V + pc * 1024))); }
}
DI bf16x8 kfrag(const LAS unsigned char* kimg, int kb  , int f  , int h, int sub, int st) { return *(const LAS bf16x8*)(kimg + kb + 8192 * sub + 16 * ((2 * st + h) ^ f)); }
DI bf16x8 vfrag(const LAS unsigned char* vimg, int vb  , int cx  , int q, int n, int sub, int s) {
    const int ch = (((n ^ q) << 2) | cx) * 16;
    const s16x4 lo = tr16(vimg + vb + ch + 256 * (32 * sub + 16 * s));
    const s16x4 hi = tr16(vimg + vb + (ch ^ 32) + 256 * (32 * sub + 16 * s + 8));
    return __builtin_shufflevector(lo, hi, 0, 1, 2, 3, 4, 5, 6, 7);
}
DI bf16x8 pack_p(const f32x16& p, int s) { u32x4 w; w.x = cvtpk(p[8 * s], p[8 * s + 1]); w.y = cvtpk(p[8 * s + 2], p[8 * s + 3]); w.z = cvtpk(p[8 * s + 4], p[8 * s + 5]); w.w = cvtpk(p[8 * s + 6], p[8 * s + 7]); return __builtin_bit_cast(bf16x8, w); }

DI void store_tile(const f32x16 (&o)[4], LAS unsigned char* stg, bf16_t* dst  , int ldo, int lane, int r, int h) {
#pragma unroll
    for (int i = 0; i < 16; ++i) { const int q = crow(i, h);
#pragma unroll
        for (int n = 0; n < 4; ++n) { const unsigned w = cvtpk(o[n][i], 0.f); *(LAS unsigned short*)(stg + q * 256 + (32 * n + r) * 2) = (unsigned short)w; } }
    asm volatile("s_waitcnt lgkmcnt(0)" ::: "memory");
#pragma unroll
    for (int it = 0; it < 8; ++it) { const int idx = it * 64 + lane, row = idx >> 4, ch = idx & 15; const u32x4 v = *(const LAS u32x4*)(stg + row * 256 + ch * 16);
        *(u32x4*)(dst + (size_t)row * ldo + ch * 8) = v; }
    asm volatile("s_waitcnt lgkmcnt(0)" ::: "memory");
}
struct LaneC { int r, h, kb, kfx, vb, cx, q4; };
DI LaneC lane_consts(int lane) { LaneC c; c.r = lane & 31; c.h = lane >> 5; c.kb = 256 * c.r; c.kfx = ((c.r & 3) << 2) | ((c.r >> 2) & 3);
    const int i16 = lane & 15, p4 = i16 & 3, gi = (lane >> 4) & 1; c.q4 = i16 >> 2; c.vb = 256 * (4 * c.h + c.q4) + 8 * (p4 & 1); c.cx = (2 * gi + (p4 >> 1)) ^ c.h; return c; }

template <bool DIAG> DI void sb_sub(const LAS unsigned char* kimg, const LAS unsigned char* vimg, int sub, const LaneC& c, const bf16x8 (&qf)[8], f32x16 (&o)[4], float& carry) {
    f32x16 s = {};
    bf16x8 kf[8];
#pragma unroll
    for (int st = 0; st < 8; ++st) kf[st] = kfrag(kimg, c.kb, c.kfx, c.h, sub, st);
    SBAR();
#pragma unroll
    for (int st = 0; st < 8; ++st) s = MFMA32(kf[st], qf[st], s);
    SBAR();
    float be[16], om[16];
#pragma unroll
    for (int i = 0; i < 16; ++i) { const float zt = s[i], t = fexp2(-fabsf(zt)), rr = frcp(1.f + t), sm = t * rr; const bool pos = zt >= 0.f;
        be[i] = pos ? rr : sm; om[i] = pos ? sm : rr;
        if (DIAG && !(crow(i, c.h) < c.r)) { be[i] = 0.f; om[i] = 1.f; } }
    SBAR();
    bf16x8 vf[8];
#pragma unroll
    for (int n = 0; n < 4; ++n) { vf[2 * n] = vfrag(vimg, c.vb, c.cx, c.q4, n, sub, 0); vf[2 * n + 1] = vfrag(vimg, c.vb, c.cx, c.q4, n, sub, 1); }
    float T[4]; f32x16 a;
#pragma unroll
    for (int g = 0; g < 4; ++g) { const float s2 = om[4 * g + 3], s1 = s2 * om[4 * g + 2], s0 = s1 * om[4 * g + 1]; T[g] = s0 * om[4 * g];
        a[4 * g + 3] = be[4 * g + 3]; a[4 * g + 2] = be[4 * g + 2] * s2; a[4 * g + 1] = be[4 * g + 1] * s1; a[4 * g] = be[4 * g] * s0; }
    float both[4], thi[4];
#pragma unroll
    for (int g = 0; g < 4; ++g) { auto rr = __builtin_amdgcn_permlane32_swap(__float_as_uint(T[g]), __float_as_uint(T[g]), false, false);
        thi[g] = __uint_as_float(rr[1]); both[g] = __uint_as_float(rr[0]) * thi[g]; }
    float G[4]; G[3] = carry; G[2] = G[3] * both[3]; G[1] = G[2] * both[2]; G[0] = G[1] * both[1];
#pragma unroll
    for (int g = 0; g < 4; ++g) { const float base = c.h == 0 ? G[g] * thi[g] : G[g];
#pragma unroll
        for (int k = 0; k < 4; ++k) a[4 * g + k] *= base; }
    carry = G[0] * both[0];
    const bf16x8 p0 = pack_p(a, 0), p1 = pack_p(a, 1);
    SBAR();
#pragma unroll
    for (int n = 0; n < 4; ++n) { o[n] = MFMA32(p0, vf[2 * n], o[n]); o[n] = MFMA32(p1, vf[2 * n + 1], o[n]);
    }
    SBAR();
}
DI void sb_unit(LAS unsigned char* lds, const bf16_t* Q, const bf16_t* K, const bf16_t* V, bf16_t* O  , int b, int hd, int qb, int useq) {
    int tid = threadIdx.x; asm volatile("" : "+v"(tid));
    const int lane = tid & 63, wid = __builtin_amdgcn_readfirstlane(tid >> 6); const LaneC c = lane_consts(lane);
    const size_t rowbase = (size_t)b * SEQ; const int t0 = qb * 256;
    const bf16_t* Kp = K + rowbase * 1024 + hd * 128; const bf16_t* Vp = V + rowbase * 1024 + hd * 128;
    const unsigned lbase = (unsigned)(size_t)lds;
    LAS int* flags = (LAS int*)(lds + L_FLAG + (useq & 1) * 32);
    if (lane == 0) flags[wid] = -1;
    const int jmax = 2 * qb + 1, mysub = 8 * qb + wid;
    unsigned voff[4]; tile_offs(voff, wid, lane);
    WAIT_BAR();
    tile_issue(Kp + (size_t)(TKEYS * jmax) * 1024, Vp + (size_t)(TKEYS * jmax) * 1024, voff, lbase, wid);
    bf16x8 qf[8];
    { const bf16_t* qrow = Q + (rowbase + t0 + 32 * wid + c.r) * 1024 + hd * 128 + 8 * c.h;
#pragma unroll
      for (int st = 0; st < 8; ++st) qf[st] = *(const bf16x8*)(qrow + 16 * st); }
    asm volatile("" : "+v"(qf[0]), "+v"(qf[1]), "+v"(qf[2]), "+v"(qf[3]), "+v"(qf[4]), "+v"(qf[5]), "+v"(qf[6]), "+v"(qf[7]));
    f32x16 o[4];
#pragma unroll
    for (int n = 0; n < 4; ++n) o[n] = (f32x16){};
    float carry = 1.f; int buf = 0; bool mydone = false;
    for (int j = jmax; j >= 0; --j) {
        WAIT_BAR();
        { const LAS i32x4* fl = (const LAS i32x4*)flags; const i32x4 fa = fl[0], fb = fl[1];
          const bool alldone = fa[0] > j && fa[1] > j && fa[2] > j && fa[3] > j && fb[0] > j && fb[1] > j && fb[2] > j && fb[3] > j;
          if (__builtin_amdgcn_readfirstlane((int)alldone)) break; }
        if (j > 0) tile_issue(Kp + (size_t)(TKEYS * (j - 1)) * 1024, Vp + (size_t)(TKEYS * (j - 1)) * 1024, voff, lbase + (buf ^ 1) * L_BUF, wid);
        const LAS unsigned char* kimg = lds + buf * L_BUF; const LAS unsigned char* vimg = kimg + L_V;
        if (!mydone) {
#pragma unroll
            for (int sub = 3; sub >= 0; --sub) { const int su = 4 * j + sub;
                if (su <= mysub) { if (su == mysub) sb_sub<true>(kimg, vimg, sub, c, qf, o, carry); else sb_sub<false>(kimg, vimg, sub, c, qf, o, carry); } }
            if (__all(carry == 0.f)) { mydone = true; if (lane == 0) flags[wid] = j; }
        }
        buf ^= 1;
    }
    WAIT_BAR();
    { int l2 = threadIdx.x & 63; asm volatile("" : "+v"(l2));
      store_tile(o, lds + L_STG + wid * 8192, O + (rowbase + t0 + 32 * wid) * 2048 + hd * 128, 2048, l2, l2 & 31, l2 >> 5); }
}

DI void da_rescale(f32x16 (&o)[4], LAS float* wsf, float f, int r, int h) {
    if (h == 0) wsf[r] = f;
    asm volatile("s_waitcnt lgkmcnt(0)" ::: "memory");
#pragma unroll
    for (int i = 0; i < 16; ++i) { const float fi = wsf[crow(i, h)];
#pragma unroll
        for (int n = 0; n < 4; ++n) o[n][i] *= fi; }
    asm volatile("s_waitcnt lgkmcnt(0)" ::: "memory");
}
DI void da_tile(const LAS unsigned char* kimg, const LAS unsigned char* vimg, int ci  , int mp, const LaneC& c, const bf16x8 (&qf)[4], f32x16 (&o)[4], f32x16& negm, float& m, float& l, bool& first, LAS float* wsf) {
    bf16x8 kf[8];
#pragma unroll
    for (int st = 0; st < 4; ++st) { kf[st] = kfrag(kimg, c.kb, c.kfx, c.h, 2 * ci, 4 * mp + st); kf[4 + st] = kfrag(kimg, c.kb, c.kfx, c.h, 2 * ci + 1, 4 * mp + st); }
    SBAR();
    f32x16 s0 = negm, s1 = negm;
#pragma unroll
    for (int st = 0; st < 4; ++st) { s0 = MFMA32(kf[st], qf[st], s0); s1 = MFMA32(kf[4 + st], qf[st], s1); }
    bf16x8 vf[8];
#pragma unroll
    for (int n = 0; n < 4; ++n) { vf[2 * n] = vfrag(vimg, c.vb, c.cx, c.q4, n, 2 * ci, 0); vf[2 * n + 1] = vfrag(vimg, c.vb, c.cx, c.q4, n, 2 * ci, 1); }
    SBAR();
    float rq[4];
#pragma unroll
    for (int k = 0; k < 4; ++k) { float r = max3f(s0[4 * k], s0[4 * k + 1], s0[4 * k + 2]); r = max3f(r, s0[4 * k + 3], s1[4 * k]); r = max3f(r, s1[4 * k + 1], s1[4 * k + 2]); rq[k] = max3f(r, s1[4 * k + 3], s1[4 * k + 3]); }
    float rm = max3f(max3f(rq[0], rq[1], rq[2]), rq[3], rq[3]);
    { auto rr = __builtin_amdgcn_permlane32_swap(__float_as_uint(rm), __float_as_uint(rm), false, false); rm = max3f(__uint_as_float(rr[0]), __uint_as_float(rr[1]), __uint_as_float(rr[1])); }
    if (first || __any(rm > 8.f)) {
        const float dl = first ? rm : fmaxf(rm, 0.f); m += dl;
#pragma unroll
        for (int i = 0; i < 16; ++i) { s0[i] -= dl; s1[i] -= dl; negm[i] = -m; }
        if (!first) { const float f = fexp2(-dl); l *= f; da_rescale(o, wsf, f, c.r, c.h); }
        first = false;
    }
    float acc = 0.f;
#pragma unroll
    for (int i = 0; i < 16; ++i) { s0[i] = fexp2(s0[i]); acc += s0[i]; }
    const bf16x8 p00 = pack_p(s0, 0), p01 = pack_p(s0, 1);
    SBAR();
    bf16x8 vg[8];
#pragma unroll
    for (int n = 0; n < 4; ++n) { o[n] = MFMA32(p00, vf[2 * n], o[n]); o[n] = MFMA32(p01, vf[2 * n + 1], o[n]);
        vg[2 * n] = vfrag(vimg, c.vb, c.cx, c.q4, n, 2 * ci + 1, 0); vg[2 * n + 1] = vfrag(vimg, c.vb, c.cx, c.q4, n, 2 * ci + 1, 1);
#pragma unroll
        for (int i = 4 * n; i < 4 * n + 4; ++i) { s1[i] = fexp2(s1[i]); acc += s1[i]; }
        SBAR(); }
    l += acc;
    const bf16x8 p10 = pack_p(s1, 0), p11 = pack_p(s1, 1);
    SBAR();
#pragma unroll
    for (int n = 0; n < 4; ++n) { o[n] = MFMA32(p10, vg[2 * n], o[n]); o[n] = MFMA32(p11, vg[2 * n + 1], o[n]); }
}
DI void da_unit(LAS unsigned char* lds, const bf16_t* Q, const bf16_t* K, const bf16_t* V, bf16_t* O  , const float* subg, int lamd  , int b, int hd, int qb  ) {
    int tid = threadIdx.x; asm volatile("" : "+v"(tid));
    const int lane = tid & 63, wid = __builtin_amdgcn_readfirstlane(tid >> 6), g = wid >> 1, mp = wid & 1; const LaneC c = lane_consts(lane);
    const size_t rowbase = (size_t)b * SEQ; const int t0 = qb * 128;
    const bf16_t* Kp = K + rowbase * 1024 + hd * 128; const bf16_t* Vp = V + rowbase * 1024 + hd * 128;
    const unsigned lbase = (unsigned)(size_t)lds;
    const int jlast = qb, myj = 2 * qb + (g >> 1);
    unsigned voff[4]; tile_offs(voff, wid, lane);
    WAIT_BAR();
    tile_issue(Kp, Vp, voff, lbase, wid);
    bf16x8 qf[4];
    { const bf16_t* qrow = Q + (rowbase + t0 + 32 * g + c.r) * 1024 + hd * 128 + 64 * mp + 8 * c.h;
#pragma unroll
      for (int st = 0; st < 4; ++st) qf[st] = *(const bf16x8*)(qrow + 16 * st); }
    asm volatile("" : "+v"(qf[0]), "+v"(qf[1]), "+v"(qf[2]), "+v"(qf[3]));
    LAS float* wsf = (LAS float*)(lds + L_WSF + wid * 256);
    f32x16 o[4];
#pragma unroll
    for (int n = 0; n < 4; ++n) o[n] = (f32x16){};
    float m = 0.f, l = 0.f; int buf = 0; bool first = true;
    f32x16 negm = {};
    for (int j = 0; j <= jlast; ++j) {
        WAIT_BAR();
        if (j < jlast) tile_issue<0, 2>(Kp + (size_t)(TKEYS * (j + 1)) * 1024, Vp + (size_t)(TKEYS * (j + 1)) * 1024, voff, lbase + (buf ^ 1) * L_BUF, wid);
        const LAS unsigned char* kimg = lds + buf * L_BUF;
        if (2 * j <= myj) da_tile(kimg, kimg + L_V, 0, mp, c, qf, o, negm, m, l, first, wsf);
        if (j < jlast) tile_issue<2, 4>(Kp + (size_t)(TKEYS * (j + 1)) * 1024, Vp + (size_t)(TKEYS * (j + 1)) * 1024, voff, lbase + (buf ^ 1) * L_BUF, wid);
        if (2 * j + 1 <= myj) da_tile(kimg, kimg + L_V, 1, mp, c, qf, o, negm, m, l, first, wsf);
        buf ^= 1;
    }
    WAIT_BAR();
    l = xhalf_sum(l);
    { int lb_ = lamd; asm volatile("" : "+s"(lb_)); const float lam = __uint_as_float((unsigned)lb_) + 0.2f;
      if (c.h == 0) wsf[c.r] = (mp ? lam : 1.f) * frcp(l); }
    asm volatile("s_waitcnt lgkmcnt(0)" ::: "memory");
#pragma unroll
    for (int i = 0; i < 16; ++i) { const float a = wsf[crow(i, c.h)];
#pragma unroll
        for (int n = 0; n < 4; ++n) o[n][i] *= a; }
    LAS float* stash = (LAS float*)(lds + L_STG + g * 16384);
    if (mp) {
#pragma unroll
        for (int i = 0; i < 16; ++i)
#pragma unroll
            for (int n = 0; n < 4; ++n) stash[(4 * i + n) * 64 + lane] = o[n][i];
    }
    WAIT_BAR();
    if (!mp) {
        float sg[4];
#pragma unroll
        for (int n = 0; n < 4; ++n) sg[n] = subg[32 * n + c.r] * 0.8f;
#pragma unroll
        for (int i = 0; i < 16; ++i) { float ss = 0.f;
#pragma unroll
            for (int n = 0; n < 4; ++n) { const float od = o[n][i] - stash[(4 * i + n) * 64 + lane]; o[n][i] = od; ss += od * od; }
            ss += swz_xor<1>(ss); ss += swz_xor<2>(ss); ss += swz_xor<4>(ss); ss += swz_xor<8>(ss); ss += swz_xor<16>(ss);
            const float rn = __builtin_amdgcn_rsqf(ss * (1.f / 128.f) + EPS);
#pragma unroll
            for (int n = 0; n < 4; ++n) o[n][i] *= rn * sg[n]; }
        asm volatile("s_waitcnt lgkmcnt(0)" ::: "memory");
        store_tile(o, lds + L_STG + g * 16384, O + (rowbase + t0 + 32 * g) * 2048 + 1024 + hd * 128, 2048, lane, c.r, c.h);
    }
}
#undef SBAR
#undef WAIT_BAR
}

constexpr size_t MiB = 1u << 20;
constexpr size_t WS_CTL = 0, CTL_ZERO_BYTES = 1 * MiB;
constexpr size_t WS_WINT = 1 * MiB;
constexpr size_t WS_WBRT = 41 * MiB;
constexpr size_t WS_WOUTT = 49 * MiB;
constexpr size_t WS_WGUT = 57 * MiB;
constexpr size_t WS_WDT = 185 * MiB;
constexpr size_t WS_WRT = 249 * MiB;
constexpr size_t WS_ROPE = 250 * MiB;
constexpr size_t WS_SSQ = 251 * MiB;
constexpr size_t WS_TOKINFO = 253 * MiB;
constexpr size_t WS_TOKW = WS_TOKINFO + 262144;
constexpr size_t WS_TOKPOS = WS_TOKW + 131072;
constexpr size_t WS_ROWGATE = WS_TOKPOS + 131072;
constexpr size_t WS_A = 254 * MiB;
constexpr size_t WS_B = 318 * MiB;
constexpr size_t WS_Y = 398 * MiB;
constexpr size_t WS_H = 558 * MiB;
constexpr size_t WS_END = 578 * MiB;
constexpr int CW_BAR = 4096, CW_CNT = 16384;

constexpr int RING_BYTES = 131072, LDSCTL_OFF = 147456, MISC_OFF = LDSCTL_OFF + 320, TST_OFF = LDSCTL_OFF + 512;
constexpr int LDS_BYTES = 147456 + 4096;

#define RLX_AGENT __ATOMIC_RELAXED, __HIP_MEMORY_SCOPE_AGENT
#define LDS_WAIT() asm volatile("s_waitcnt lgkmcnt(0)" ::: "memory")

#define XB_TMO      128
#define XB_XCNT(j)  (256  + 64 * (j))
#define XB_XSUB(j)  (1280 + 64 * (j))
#define XB_XGEN(j)  (2304 + 64 * (j))
#define XB_TOP      3328
#define XB_TOPGEN   3392
#define XCD_BAR_WORDS 3456
#define XB_SPIN_CAP (1u << 18)
DI unsigned xb_ld(unsigned* p)              { return __hip_atomic_load(p, __ATOMIC_RELAXED, __HIP_MEMORY_SCOPE_AGENT); }
DI unsigned xb_add(unsigned* p, unsigned v) { return __hip_atomic_fetch_add(p, v, __ATOMIC_RELAXED, __HIP_MEMORY_SCOPE_AGENT); }
DI unsigned xb_xcc_id() { return (unsigned)__builtin_amdgcn_s_getreg((3 << 11) | 20) & 0xFu; }
#define XB_SPIN(cond, bar) do { unsigned _sp = 0; while (cond) { __builtin_amdgcn_s_sleep(1); \
    if ((++_sp & 255u) == 0u) { if (xb_ld(&(bar)[XB_TMO])) break; if (_sp > XB_SPIN_CAP) { atomicAdd(&(bar)[XB_TMO], 1u); break; } } } } while (0)
struct XcdBarrier { unsigned* bar; unsigned x; volatile LAS unsigned* st; };
DI XcdBarrier xcd_barrier_post(unsigned* bar, volatile LAS unsigned* st) {
    XcdBarrier b; b.bar = bar; b.x = xb_xcc_id(); b.st = st;
    if (threadIdx.x == 0) (void)xb_add(&bar[XB_XCNT(b.x)], 1u);
    return b;
}
DI void xcd_barrier_complete(unsigned* bar, unsigned x, unsigned& nloc, unsigned& nx) {
    const unsigned G = gridDim.x * gridDim.y * gridDim.z;
    unsigned sum, cnt, mine, sp = 0u;
    for (;;) {
        sum = 0u; cnt = 0u; mine = 0u;
#pragma unroll
        for (unsigned j = 0; j < 16; ++j) { const unsigned c = xb_ld(&bar[XB_XCNT(j)]); sum += c; cnt += (c > 0u) ? 1u : 0u; mine = (j == x) ? c : mine; }
        if (sum == G) break;
        __builtin_amdgcn_s_sleep(1);
        if ((++sp & 255u) == 0u) { if (xb_ld(&bar[XB_TMO])) break; if (sp > XB_SPIN_CAP) { atomicAdd(&bar[XB_TMO], 1u); break; } }
    }
    nloc = mine > 0u ? mine : 1u; nx = cnt > 0u ? cnt : 1u;
}
DI void xcd_barrier(const XcdBarrier& b) {
    asm volatile("s_waitcnt vmcnt(0)" ::: "memory");
    __syncthreads();
    if (threadIdx.x == 0) {
        unsigned* bar = b.bar;
        __builtin_amdgcn_s_waitcnt(0);
        unsigned nloc = b.st[0], nx = b.st[1];
        if (nloc == 0u) { xcd_barrier_complete(bar, b.x, nloc, nx); b.st[0] = nloc; b.st[1] = nx; }
        const unsigned old = xb_add(&bar[XB_XSUB(b.x)], 1u);
        const unsigned gen = old / nloc;
        if (old + 1u == (gen + 1u) * nloc) {
            __builtin_amdgcn_fence(__ATOMIC_RELEASE, "agent");
            asm volatile("s_waitcnt vmcnt(0)" ::: "memory");
            const unsigned og = xb_add(&bar[XB_TOP], 1u);
            const unsigned tg = og / nx;
            if (og + 1u == (tg + 1u) * nx) xb_add(&bar[XB_TOPGEN], 1u);
            else XB_SPIN(xb_ld(&bar[XB_TOPGEN]) == tg, bar);
            __builtin_amdgcn_fence(__ATOMIC_ACQUIRE, "agent");
            asm volatile("s_waitcnt vmcnt(0)" ::: "memory");
        } else {
            XB_SPIN(xb_ld(&bar[XB_TOPGEN]) == gen, bar);
            __builtin_amdgcn_fence(__ATOMIC_ACQUIRE, "agent");
            asm volatile("s_waitcnt vmcnt(0)" ::: "memory");
        }
    }
    __syncthreads();
}

struct Args {
    const float* x; const float* mix_g; const float* w_in; const float* lq1; const float* lk1; const float* lq2; const float* lk2; const float* subg;
    const float* w_bsb; const float* w_bd; const float* w_out; const float* ffn_g; const float* w_gr; const float* w_er; const float* w_gate; const float* w_up; const float* w_down; const float* fin_g;
    float* out; unsigned char* ws;
};

template <int MODE> DI int drow_of(int n) {
    if (MODE == 1) { const int pn = n >> 8; if (pn < 12 || pn >= 20) return n; const int lc = n & 255; return (pn << 8) + 128 * ((lc >> 5) & 1) + 32 * (lc >> 6) + (lc & 31); }
    if (MODE == 2) return 256 * (n >> 7) + (n & 127);
    if (MODE == 3) return 256 * (n >> 7) + 128 + (n & 127);
    return n;
}
template <int MODE> DI void transpose_item(const float* W, int N, int k0, int n0, bf16_t* WT, int ldk, int koff, LAS unsigned char* scr, int lane) {
    const int g = lane >> 4, l16 = lane & 15;
    f32x4 v[16];
#pragma unroll
    for (int i = 0; i < 16; ++i) { const int kk = 8 * (i >> 1) + 2 * g + (i & 1); v[i] = __builtin_nontemporal_load((const f32x4*)(W + (size_t)(k0 + kk) * N + n0 + 4 * l16)); }
#pragma unroll
    for (int m = 0; m < 8; ++m)
#pragma unroll
        for (int jj = 0; jj < 4; ++jj) { const int n = 4 * l16 + jj; *(LAS unsigned*)(scr + n * 128 + (((4 * m + g) ^ ((l16 & 7) << 2)) * 4)) = cvtpk(v[2 * m][jj], v[2 * m + 1][jj]); }
    LDS_WAIT(); asm volatile("" ::: "memory");
#pragma unroll
    for (int it = 0; it < 8; ++it) { const int n = it * 8 + (lane >> 3), c = lane & 7; const u32x4 o = *(const LAS u32x4*)(scr + n * 128 + ((c ^ ((n >> 2) & 7)) * 16));
        *(u32x4*)(WT + (size_t)drow_of<MODE>(n0 + n) * ldk + koff + k0 + 8 * c) = o; }
    LDS_WAIT(); asm volatile("" ::: "memory");
}

template <int MODE> DI int drow8_of(int n) { if (MODE == 4) return 8 * (n >> 2) + (n & 3); if (MODE == 5) return 8 * (n >> 2) + 4 + (n & 3);
    if (MODE == 6) { const int t = n >> 11, cc = n & 2047; return 128 * (cc >> 6) + 64 * ((cc >> 5) & 1) + 32 * t + (cc & 31); }
    return n; }
template <int MODE> DI void transpose_item8(const float* W, int N, int k0, int n0, unsigned char* WT, int ldk, float scale, LAS unsigned char* scr, int lane) {
    const int g = lane >> 4, l16 = lane & 15;
    f32x4 v[16];
#pragma unroll
    for (int i = 0; i < 16; ++i) { const int kk = 16 * (i >> 2) + 4 * g + (i & 3); v[i] = __builtin_nontemporal_load((const f32x4*)(W + (size_t)(k0 + kk) * N + n0 + 4 * l16)); }
#pragma unroll
    for (int b = 0; b < 4; ++b)
#pragma unroll
        for (int jj = 0; jj < 4; ++jj) { const int n = 4 * l16 + jj; *(LAS unsigned*)(scr + n * 64 + (((4 * b + g) ^ l16) * 4)) = pk4_fp8(v[4 * b][jj] * scale, v[4 * b + 1][jj] * scale, v[4 * b + 2][jj] * scale, v[4 * b + 3][jj] * scale); }
    LDS_WAIT(); asm volatile("" ::: "memory");
#pragma unroll
    for (int it = 0; it < 4; ++it) { const int n = it * 16 + (lane >> 2), c = lane & 3, s = (n >> 2) & 15; u32x4 o;
#pragma unroll
        for (int t = 0; t < 4; ++t) o[t] = *(const LAS unsigned*)(scr + n * 64 + (((4 * c + t) ^ s) * 4));
        *(u32x4*)(WT + (size_t)drow8_of<MODE>(n0 + n) * ldk + k0 + 16 * c) = o; }
    LDS_WAIT(); asm volatile("" ::: "memory");
}

typedef float f32x16v __attribute__((ext_vector_type(16)));
DI void fp6_slot_store(unsigned char* rowp  , int s, const f32x16v lo, const f32x16v hi) {
    const auto d = __builtin_amdgcn_cvt_scalef32_2xpk16_fp6_f32(lo, hi, 1.0f);
    unsigned char* p = rowp + (s >> 2) * 128 + 16 * (s & 3);
    *(u32x4*)p = (u32x4){(unsigned)d[0], (unsigned)d[1], (unsigned)d[2], (unsigned)d[3]}; *(u32x2*)(p + 64) = (u32x2){(unsigned)d[4], (unsigned)d[5]};
}
DI void fp6_weight_item(const float* W, int N, int s, int n0, unsigned char* WT, float scale, int lane) {
    f32x16v lo, hi;
#pragma unroll
    for (int j = 0; j < 8; ++j)
#pragma unroll
        for (int i = 0; i < 4; ++i) { const float v = __builtin_nontemporal_load(W + (size_t)(4 * s + 256 * j + i) * N + n0 + lane) * scale; if (j < 4) lo[4 * j + i] = v; else hi[4 * (j - 4) + i] = v; }
    fp6_slot_store(WT + (size_t)drow8_of<6>(n0 + lane) * 2048, s, lo, hi);
}
DI void rms_row_bf16(const float* xrow, const f32x4 (&g)[8]  , bf16_t* orow, unsigned char* orow8, int lane) {
    const f32x4* xr = (const f32x4*)xrow + lane; f32x4 v[8]; float s = 0.f;
#pragma unroll
    for (int j = 0; j < 8; ++j) { v[j] = __builtin_nontemporal_load(xr + 64 * j); s += (v[j][0] * v[j][0] + v[j][1] * v[j][1]) + (v[j][2] * v[j][2] + v[j][3] * v[j][3]); }
    const float rs = __builtin_amdgcn_rsqf(wave_sum(s) * (1.f / DM) + EPS);
    u32x2* o8 = (u32x2*)orow + lane;
    f32x16v lo, hi;
#pragma unroll
    for (int j = 0; j < 8; ++j) { const f32x4 gg = g[j]; const float e0 = v[j][0] * rs * gg[0], e1 = v[j][1] * rs * gg[1], e2 = v[j][2] * rs * gg[2], e3 = v[j][3] * rs * gg[3];
        u32x2 w; w.x = cvtpk(e0, e1); w.y = cvtpk(e2, e3); o8[64 * j] = w;
        if (j < 4) { lo[4 * j] = 2.f * e0; lo[4 * j + 1] = 2.f * e1; lo[4 * j + 2] = 2.f * e2; lo[4 * j + 3] = 2.f * e3; } else { hi[4 * j - 16] = 2.f * e0; hi[4 * j - 15] = 2.f * e1; hi[4 * j - 14] = 2.f * e2; hi[4 * j - 13] = 2.f * e3; } }
    fp6_slot_store(orow8, lane, lo, hi);
}

constexpr int NWAVES = 8;
__global__ void __launch_bounds__(NWAVES * 64, 2) hybrid_fwd(Args args) {
    extern __shared__ __attribute__((aligned(16))) unsigned char lds_raw[];
    LAS unsigned char* lds = (LAS unsigned char*)lds_raw;
    const int tid = threadIdx.x, lane = tid & 63, wave = __builtin_amdgcn_readfirstlane(tid >> 6);
    const int G = gridDim.x, bx = blockIdx.x;
    const int vcu = (G % 8 == 0) ? (bx % 8) * (G / 8) + bx / 8 : bx;
#define KA_DECL const __attribute__((address_space(4))) Args* ka = (const __attribute__((address_space(4))) Args*)__builtin_amdgcn_kernarg_segment_ptr(); asm volatile("" : "+s"(ka)); \
    unsigned char* const ws = ka->ws; (void)ws; \
    int tid = threadIdx.x; asm volatile("" : "+v"(tid)); const int lane = tid & 63; (void)lane
#define P_WINT ((bf16_t*)(ws + WS_WINT))
#define P_WBRT ((bf16_t*)(ws + WS_WBRT))
#define P_WOUTT ((bf16_t*)(ws + WS_WOUTT))
#define P_WGUT8 ((unsigned char*)(ws + WS_WGUT))
#define P_WDT8 ((unsigned char*)(ws + WS_WDT))
#define P_WRT ((bf16_t*)(ws + WS_WRT))
#define P_ROPE ((f32x2*)(ws + WS_ROPE))
#define P_SSQ ((float*)(ws + WS_SSQ))
#define P_TOKINFO ((int*)(ws + WS_TOKINFO))
#define P_TOKW ((float*)(ws + WS_TOKW))
#define P_TOKPOS ((int*)(ws + WS_TOKPOS))
#define P_ROWGATE ((float*)(ws + WS_ROWGATE))
#define P_BUFA ((bf16_t*)(ws + WS_A))
#define P_BUFB ((bf16_t*)(ws + WS_B))
#define P_HB8 ((unsigned char*)(ws + WS_H))
#define P_XS8 ((unsigned char*)(ws + WS_B))
#define P_YB8 ((unsigned char*)(ws + WS_Y))
#define P_H8IN ((unsigned char*)(ws + (size_t)512 * MiB))
#define P_WING8 ((unsigned char*)(ws + WS_WINT + (size_t)24 * MiB))
#define P_GSB ((bf16_t*)ka->out)
#define P_GDA ((bf16_t*)ka->out + (size_t)NTOK * 2048)
#define P_CTAB ((int*)(ws + WS_CTL + 65536))
    volatile LAS unsigned* MISC = (volatile LAS unsigned*)(lds + MISC_OFF);
    LAS int* tstart = (LAS int*)(lds + TST_OFF);
    for (int u = tid; u < (LDS_BYTES - RING_BYTES) / 4; u += NWAVES * 64) ((LAS unsigned*)(lds + RING_BYTES))[u] = 0u;
    __syncthreads();
    XcdBarrier bar;
    { KA_DECL; bar = xcd_barrier_post((unsigned*)(ws + WS_CTL) + CW_BAR, MISC + 8); }
    const int gw = vcu * NWAVES + wave, NGW = G * NWAVES;

#if DBG_STAGE != 1
    if (PH(0)) for (int rep_ = 0; rep_ < kReps[0]; ++rep_) { KA_DECL;
        LAS unsigned char* scr = lds + wave * 16384;
        constexpr int I_IN = 32 * 96, I_G6 = 64 * 64, I_BR = 16 * 32, I_OUT = 32 * 32, I_G = 32 * 8, I_D = 8 * 32;
        constexpr int NITEMS = I_IN + I_G6 + 2 * I_BR + I_OUT + 32 * (2 * I_G + I_D);
        for (int it = gw; it < NITEMS; it += NGW) {
            int r = it;
            if (r < I_IN) { const int kb = r / 96, nb = r % 96; transpose_item<1>(ka->w_in, INC, 64 * kb, 64 * nb, P_WINT, 2048, 0, scr, lane); continue; } r -= I_IN;
            if (r < I_G6) { fp6_weight_item(ka->w_in + 6144, INC, r >> 6, 64 * (r & 63), P_WING8, 64.f, lane); continue; } r -= I_G6;
            if (r < I_BR) { const int kb = r / 32, nb = r % 32; transpose_item<0>(ka->w_bsb, 2048, 64 * kb, 64 * nb, P_WBRT, 2048, 0, scr, lane); continue; } r -= I_BR;
            if (r < I_BR) { const int kb = r / 32, nb = r % 32; transpose_item<0>(ka->w_bd, 2048, 64 * kb, 64 * nb, P_WBRT, 2048, 1024, scr, lane); continue; } r -= I_BR;
            if (r < I_OUT) { const int kb = r / 32, nb = r % 32; transpose_item<0>(ka->w_out, 2048, 64 * kb, 64 * nb, P_WOUTT, 2048, 0, scr, lane); continue; } r -= I_OUT;
            if (r < 32 * I_G) { const int e = r / I_G, q = r % I_G, kb = q / 8, nb = q % 8;
                transpose_item8<4>(ka->w_gate + (size_t)e * 2048 * 512, 512, 64 * kb, 64 * nb, P_WGUT8 + (size_t)e * 1024 * 2048, 2048, 64.f, scr, lane); continue; } r -= 32 * I_G;
            if (r < 32 * I_G) { const int e = r / I_G, q = r % I_G, kb = q / 8, nb = q % 8;
                transpose_item8<5>(ka->w_up + (size_t)e * 2048 * 512, 512, 64 * kb, 64 * nb, P_WGUT8 + (size_t)e * 1024 * 2048, 2048, 64.f, scr, lane); continue; } r -= 32 * I_G;
            { const int e = r / I_D, q = r % I_D, kb = q / 32, nb = q % 32;
                transpose_item8<0>(ka->w_down + (size_t)e * 512 * 2048, 2048, 64 * kb, 64 * nb, P_WDT8 + (size_t)e * 2048 * 512, 512, 32.f, scr, lane); }
        }
        for (int idx = bx * 512 + tid; idx < SEQ * 32; idx += G * 512) {
            const int pos = idx >> 5, i = idx & 31;
            const float invf = __builtin_amdgcn_exp2f(-(float)i * (13.287712379549449f / 32.f));
            const float ang = (float)pos * invf;
            double rev = (double)ang * 0.15915494309189535; rev -= __builtin_floor(rev);
            const float rf = (float)rev;
            P_ROPE[idx] = (f32x2){__builtin_amdgcn_cosf(rf), __builtin_amdgcn_sinf(rf)};
        }
        for (int idx = bx * 512 + tid; idx < 64 * 2048; idx += G * 512) {
            const int j = idx >> 11, k = idx & 2047; float v = 0.f;
            if (j < 4) v = ka->w_gr[k * 4 + j] * ka->ffn_g[k]; else if (j < 36) v = ka->w_er[k * 32 + (j - 4)] * ka->ffn_g[k];
            P_WRT[idx] = (bf16_t)(cvtpk(v, 0.f) & 0xffffu);
        }
        { f32x4 mg[8];
#pragma unroll
          for (int j = 0; j < 8; ++j) mg[j] = ((const f32x4*)ka->mix_g)[lane + 64 * j];
          for (int m = gw; m < NTOK; m += NGW) rms_row_bf16(ka->x + (size_t)m * DM, mg, P_BUFA + (size_t)m * DM, P_H8IN + (size_t)m * DM, lane); }
        xcd_barrier(bar);
    }

    if (PH(1)) for (int rep_ = 0; rep_ < kReps[1]; ++rep_) { KA_DECL;
#ifndef STAGGER_TICKS
#define STAGGER_TICKS 0
#endif
        if (STAGGER_TICKS) { const unsigned long long t0 = __builtin_amdgcn_s_memrealtime(), dl = (unsigned long long)(((bx >> 3) & 7) * STAGGER_TICKS);
            while (__builtin_amdgcn_s_memrealtime() - t0 < dl) __builtin_amdgcn_s_sleep(8); }
        { pg8::Gemm g{P_BUFA, P_WINT, NTOK, 6144, DM}; pg8::StaticOrder S; S.init(NTOK, 6144, G, bx);
          pg8::EpiInProj E{P_BUFB, P_ROPE};
          pg8::gemm_phase<pg8::EpiInProj, pg8::StaticOrder, true, true>(lds, g, S, E); }
        { pg8::Gemm g{(const bf16_t*)P_H8IN, (const bf16_t*)P_WING8, NTOK, 4096, DM / 2}; pg8::StaticOrder S; S.init(NTOK, 2 * 4096, G, bx);
          pg8::EpiGate2 E{P_GSB, P_GDA};
          pg8::gemm_f8v2_phase<pg8::EpiGate2, pg8::StaticOrder, 127 - 6, 127 - 1, 2>(lds, g, S, E); }
        xcd_barrier(bar);
    }

    if (PH(2)) for (int rep_ = 0; rep_ < kReps[2]; ++rep_) { KA_DECL;
        const float a = ka->lq1[lane] * ka->lk1[lane], b2 = ka->lq2[lane] * ka->lk2[lane];
        const int lamd = __builtin_amdgcn_readfirstlane((int)__float_as_uint(__expf(wave_sum(a)) - __expf(wave_sum(b2))));
        const bf16_t* qsb = P_BUFB; const bf16_t* ksb = P_BUFB + (size_t)NTOK * 1024; const bf16_t* vsb = P_BUFB + (size_t)2 * NTOK * 1024;
        const bf16_t* qda = P_BUFB + (size_t)3 * NTOK * 1024; const bf16_t* kda = P_BUFB + (size_t)4 * NTOK * 1024; const bf16_t* vda = P_BUFB + (size_t)5 * NTOK * 1024;
        for (int u = vcu; u < 256; u += G) {
            const int bh = u >> 2, pi = u & 3, b = bh >> 3, hd = bh & 7;
#ifndef ATT_MASK
#define ATT_MASK 3
#endif
            if (ATT_MASK & 1) for (int k = 0; k < 2 * REP_SB; ++k) att::sb_unit(lds, qsb, ksb, vsb, P_BUFA, b, hd, (k & 1) == 0 ? 7 - pi : pi, k);
            if (ATT_MASK & 2) for (int k = 0; k < 4 * REP_DA; ++k) att::da_unit(lds, qda, kda, vda, P_BUFA, ka->subg, lamd, b, hd, (k & 1) ? 2 * pi + ((k >> 1) & 1) : 15 - 2 * pi - ((k >> 1) & 1));
        }
        xcd_barrier(bar);
    }

    if (PH(3)) for (int rep_ = 0; rep_ < kReps[3]; ++rep_) { KA_DECL;
        pg8::Gemm g{P_BUFA, P_WBRT, NTOK, DM, DM}; pg8::StaticOrder S; S.init(NTOK, DM, G, bx);
        pg8::EpiMerged E{P_GSB, P_GDA, P_BUFB};
        pg8::gemm_phase<pg8::EpiMerged, pg8::StaticOrder, true, true>(lds, g, S, E);
        xcd_barrier(bar);
    }

    if (PH(4)) for (int rep_ = 0; rep_ < kReps[4]; ++rep_) { KA_DECL;
        pg8::Gemm g{P_BUFB, P_WOUTT, NTOK, DM, DM}; pg8::StaticOrder S; S.init(NTOK, DM, G, bx);
        pg8::EpiX1 E{ka->x, P_BUFA, P_SSQ};
        pg8::gemm_phase<pg8::EpiX1, pg8::StaticOrder, true, true>(lds, g, S, E);
        xcd_barrier(bar);
    }
#endif

#if DBG_STAGE == 0
    if (PH(5)) for (int rep_ = 0; rep_ < kReps[5]; ++rep_) { KA_DECL;
        constexpr int PSTR = 64 * 56;
        LAS float* part = (LAS float*)lds; LAS float* Lg = (LAS float*)(lds + 8 * PSTR * 4);
        LAS int* hist = (LAS int*)(lds + 131072);
        const int fr = lane & 15, fq = lane >> 4;
        for (int tb = bx; tb < NTOK / 64; tb += G) {
            if (tid < 32) hist[tid] = 0;
            const f32x4 sv = *(const f32x4*)(P_SSQ + (size_t)(tb * 64 + (tid >> 3)) * 32 + 4 * (tid & 7));
            bf16x8 bv[8][3];
            { const bf16_t* bp = P_WRT + (size_t)fr * DM + 256 * wave + 8 * fq;
#pragma unroll
              for (int kk = 0; kk < 8; ++kk)
#pragma unroll
                  for (int nt = 0; nt < 3; ++nt) bv[kk][nt] = *(const bf16x8*)(bp + (size_t)16 * nt * DM + 32 * kk); }
#pragma unroll 1
            for (int tp = 0; tp < 2; ++tp) {
                bf16x8 av[2][8]; f32x4 acc[2][3];
#pragma unroll
                for (int u = 0; u < 2; ++u) { const bf16_t* ap = P_BUFA + (size_t)(tb * 64 + 16 * (2 * tp + u) + fr) * DM + 256 * wave + 8 * fq;
#pragma unroll
                    for (int kk = 0; kk < 8; ++kk) av[u][kk] = *(const bf16x8*)(ap + 32 * kk);
#pragma unroll
                    for (int nt = 0; nt < 3; ++nt) acc[u][nt] = (f32x4){0.f, 0.f, 0.f, 0.f}; }
#pragma unroll
                for (int u = 0; u < 2; ++u)
#pragma unroll
                    for (int kk = 0; kk < 8; ++kk)
#pragma unroll
                        for (int nt = 0; nt < 3; ++nt) acc[u][nt] = __builtin_amdgcn_mfma_f32_16x16x32_bf16(av[u][kk], bv[kk][nt], acc[u][nt], 0, 0, 0);
#pragma unroll
                for (int u = 0; u < 2; ++u)
#pragma unroll
                    for (int nt = 0; nt < 3; ++nt)
#pragma unroll
                        for (int rg = 0; rg < 4; ++rg) part[wave * PSTR + (16 * (2 * tp + u) + 4 * fq + rg) * 56 + 16 * nt + fr] = acc[u][nt][rg];
            }
            __syncthreads();
            { const int t = tid >> 3, j = tid & 7;
              float ss = (sv[0] + sv[1]) + (sv[2] + sv[3]);
              ss += swzx<1>(ss); ss += swzx<2>(ss); ss += swzx<4>(ss);
              const float rsv = __builtin_amdgcn_rsqf(ss * (1.f / DM) + EPS);
#pragma unroll
              for (int i = 0; i < 6; ++i) { float v = 0.f;
#pragma unroll
                  for (int w = 0; w < 8; ++w) v += part[w * PSTR + t * 56 + j + 8 * i];
                  Lg[t * 64 + j + 8 * i] = v * rsv; } }
            __syncthreads();
            int ex0 = 0, ex1 = 0, lr0 = 0, lr1 = 0; float w0 = 0.f, w1 = 0.f; const bool router = (wave < 4 && lane < 16); const int tok0 = tb * 64 + 16 * wave;
            { LAS float* lg = Lg + 16 * wave * 64;
            if (router) {
                const LAS float* L = lg + lane * 64;
                float g0 = L[0]; int grp = 0;
#pragma unroll
                for (int j = 1; j < 4; ++j) { const float v = L[j]; if (v > g0) { g0 = v; grp = j; } }
                float den = 0.f;
#pragma unroll
                for (int j = 0; j < 4; ++j) den += __expf(L[j] - g0);
                const float pg = 1.f / den;
                const LAS float* E = L + 4 + 8 * grp;
                float v0 = E[0]; int i0 = 0;
#pragma unroll
                for (int j = 1; j < 8; ++j) { const float v = E[j]; if (v > v0) { v0 = v; i0 = j; } }
                float v1 = -3.0e38f; int i1 = 0;
#pragma unroll
                for (int j = 0; j < 8; ++j) { const float v = E[j]; if (j != i0 && v > v1) { v1 = v; i1 = j; } }
                const float e1 = __expf(v1 - v0); w0 = pg / (1.f + e1); w1 = pg * e1 / (1.f + e1);
                ex0 = grp * 8 + i0; ex1 = grp * 8 + i1;
                lr0 = __hip_atomic_fetch_add(hist + ex0, 1, __ATOMIC_RELAXED, __HIP_MEMORY_SCOPE_WORKGROUP); lr1 = __hip_atomic_fetch_add(hist + ex1, 1, __ATOMIC_RELAXED, __HIP_MEMORY_SCOPE_WORKGROUP);
            }
            LDS_WAIT(); asm volatile("" ::: "memory");
            }
            if (router) { const int t = tok0 + lane;
                *(int4*)(P_TOKINFO + 4 * (size_t)t) = make_int4(ex0, lr0, ex1, lr1);
                *(float2*)(P_TOKW + 2 * (size_t)t) = make_float2(w0, w1); }
            __syncthreads();
            if (tid < 32) P_CTAB[tb * 32 + tid] = hist[tid];
            __syncthreads();
        }
        xcd_barrier(bar);
    }

    if (PH(6)) for (int rep_ = 0; rep_ < kReps[6]; ++rep_) { KA_DECL;
        LAS int* ptab = (LAS int*)lds;
        static_assert(NTOK / 64 == 256, "one wave scans 256 blocks as 64 lanes x 4");
#pragma unroll
        for (int k = 0; k < 4; ++k) { const int e = 4 * wave + k;
            const int v0 = P_CTAB[(4 * lane) * 32 + e], v1 = P_CTAB[(4 * lane + 1) * 32 + e], v2 = P_CTAB[(4 * lane + 2) * 32 + e], v3 = P_CTAB[(4 * lane + 3) * 32 + e];
            const int s0 = v0, s1 = s0 + v1, s2 = s1 + v2, s3 = s2 + v3; int incl = s3;
#pragma unroll
            for (int d = 1; d < 64; d <<= 1) { const int n = __shfl_up(incl, d); if (lane >= d) incl += n; }
            const int ex = incl - s3;
            *(LAS i32x4*)(ptab + e * 256 + 4 * lane) = (i32x4){ex, ex + s0, ex + s1, ex + s2};
            if (lane == 63) ptab[8192 + e] = incl; }
        __syncthreads();
        if (wave == 0) { const int cnt = (lane < 32) ? (ptab[8192 + (lane & 31)] + 255) >> 8 : 0; int incl = cnt;
#pragma unroll
            for (int d = 1; d < 32; d <<= 1) { const int n = __shfl_up(incl, d); if (lane >= d) incl += n; }
            if (lane < 32) tstart[lane] = incl - cnt;
            if (lane == 31) tstart[32] = incl; }
        __syncthreads();
        f32x4 gq[8];
#pragma unroll
        for (int q = 0; q < 8; ++q) gq[q] = ((const f32x4*)ka->ffn_g + 8 * lane)[q];
        for (int t0 = gw; t0 < NTOK; t0 += 2 * NGW) {
            const int tt[2] = {t0, (t0 + NGW < NTOK) ? t0 + NGW : t0};
            int4 ti[2]; float sq[2]; u32x4 xv[2][4];
#pragma unroll
            for (int u = 0; u < 2; ++u) { ti[u] = *(const int4*)(P_TOKINFO + 4 * (size_t)tt[u]); sq[u] = (lane < 32) ? P_SSQ[(size_t)tt[u] * 32 + lane] : 0.f;
                const u32x4* src = (const u32x4*)(P_BUFA + (size_t)tt[u] * DM) + 4 * lane;
#pragma unroll
                for (int q = 0; q < 4; ++q) xv[u][q] = src[q]; }
#pragma unroll
            for (int u = 0; u < 2; ++u) {
                const int pb = tt[u] >> 6, pos0 = 256 * tstart[ti[u].x] + ptab[ti[u].x * 256 + pb] + ti[u].y, pos1 = 256 * tstart[ti[u].z] + ptab[ti[u].z * 256 + pb] + ti[u].w;
                const float rs = __builtin_amdgcn_rsqf(wave_sum(sq[u]) * (1.f / DM) + EPS);
                u32x4 o[2];
#pragma unroll
                for (int q = 0; q < 4; ++q) { const u32x4 v = xv[u][q]; const f32x4 g0 = gq[2 * q], g1 = gq[2 * q + 1];
                    const unsigned w0 = pk4_fp8_sat(bflo(v.x) * rs * g0[0], bfhi(v.x) * rs * g0[1], bflo(v.y) * rs * g0[2], bfhi(v.y) * rs * g0[3]);
                    const unsigned w1 = pk4_fp8_sat(bflo(v.z) * rs * g1[0], bfhi(v.z) * rs * g1[1], bflo(v.w) * rs * g1[2], bfhi(v.w) * rs * g1[3]);
                    o[q >> 1][(q & 1) * 2] = w0; o[q >> 1][(q & 1) * 2 + 1] = w1; }
                { u32x4* d0 = (u32x4*)(P_XS8 + (size_t)pos0 * DM) + 2 * lane; u32x4* d1 = (u32x4*)(P_XS8 + (size_t)pos1 * DM) + 2 * lane; d0[0] = o[0]; d0[1] = o[1]; d1[0] = o[0]; d1[1] = o[1]; }
                if (lane == 0) *(int2*)(P_TOKPOS + 2 * (size_t)tt[u]) = make_int2(pos0, pos1);
            }
        }
        xcd_barrier(bar);
    }

    if (PH(7)) for (int rep_ = 0; rep_ < kReps[7]; ++rep_) { KA_DECL;
        pg8::Gemm g{(const bf16_t*)P_XS8, (const bf16_t*)P_WGUT8, PROWS, 1024, DM / 2}; pg8::MoeOrder S{tstart, 8, G, bx};
        pg8::EpiSwiglu2 E{P_HB8};
        pg8::gemm_f8v2_phase<pg8::EpiSwiglu2, pg8::MoeOrder, 127 - 6, 127>(lds, g, S, E);
        xcd_barrier(bar);
    }

    if (PH(8)) for (int rep_ = 0; rep_ < kReps[8]; ++rep_) { KA_DECL;
        pg8::Gemm g{(const bf16_t*)P_HB8, (const bf16_t*)P_WDT8, PROWS, 2048, DE / 2}; pg8::MoeOrder S{tstart, 16, G, bx};
        pg8::EpiDown2 E{P_YB8};
        pg8::gemm_f8v2_phase<pg8::EpiDown2, pg8::MoeOrder, 127 - 5, 127>(lds, g, S, E);
        xcd_barrier(bar);
    }
#endif

    if (PH(9)) for (int rep_ = 0; rep_ < kReps[9]; ++rep_) { KA_DECL;
    f32x4 fg[8];
#pragma unroll
    for (int j = 0; j < 8; ++j) fg[j] = ((const f32x4*)ka->fin_g)[lane + 64 * j];
#if DBG_STAGE == 0
    for (int t0 = gw; t0 < NTOK; t0 += 2 * NGW) {
        const int tt[2] = {t0, (t0 + NGW < NTOK) ? t0 + NGW : t0};
        u32x2 xw[2][8]; unsigned ya[2][8], yb[2][8]; float wa[2], wb[2];
#pragma unroll
        for (int u = 0; u < 2; ++u) { const int2 tp = *(const int2*)(P_TOKPOS + 2 * (size_t)tt[u]); const float2 tw = *(const float2*)(P_TOKW + 2 * (size_t)tt[u]); wa[u] = tw.x * (1.f / 32.f); wb[u] = tw.y * (1.f / 32.f);
            const u32x2* xr = (const u32x2*)(P_BUFA + (size_t)tt[u] * DM) + lane; const unsigned* pa = (const unsigned*)(P_YB8 + (size_t)tp.x * DM) + lane; const unsigned* pb = (const unsigned*)(P_YB8 + (size_t)tp.y * DM) + lane;
#pragma unroll
            for (int j = 0; j < 8; ++j) { xw[u][j] = xr[64 * j]; ya[u][j] = pa[64 * j]; yb[u][j] = pb[64 * j]; } }
#pragma unroll
        for (int u = 0; u < 2; ++u) { f32x4 v[8]; float s = 0.f;
#pragma unroll
            for (int j = 0; j < 8; ++j) { const u32x2 w = xw[u][j]; const int a = (int)ya[u][j], b = (int)yb[u][j];
                const f32x2 a0 = __builtin_amdgcn_cvt_pk_f32_fp8(a, false), a1 = __builtin_amdgcn_cvt_pk_f32_fp8(a, true), b0 = __builtin_amdgcn_cvt_pk_f32_fp8(b, false), b1 = __builtin_amdgcn_cvt_pk_f32_fp8(b, true);
                v[j] = (f32x4){bflo(w.x) + (a0[0] * wa[u] + b0[0] * wb[u]), bfhi(w.x) + (a0[1] * wa[u] + b0[1] * wb[u]), bflo(w.y) + (a1[0] * wa[u] + b1[0] * wb[u]), bfhi(w.y) + (a1[1] * wa[u] + b1[1] * wb[u])};
                s += (v[j][0] * v[j][0] + v[j][1] * v[j][1]) + (v[j][2] * v[j][2] + v[j][3] * v[j][3]); }
            const float rs = __builtin_amdgcn_rsqf(wave_sum(s) * (1.f / DM) + EPS);
            if (u == 0 || tt[1] != tt[0]) { f32x4* orow = (f32x4*)(ka->out + (size_t)tt[u] * DM) + lane;
#pragma unroll
                for (int j = 0; j < 8; ++j) orow[64 * j] = v[j] * rs * fg[j]; } }
    }
#else
    for (int t = gw; t < NTOK; t += NGW) {
        f32x4 v[8];
#if DBG_STAGE == 1
        { const f32x4* xr = (const f32x4*)(ka->x + (size_t)t * DM) + lane;
#pragma unroll
          for (int j = 0; j < 8; ++j) v[j] = xr[64 * j]; }
#else
        { const u32x2* xr = (const u32x2*)(P_BUFA + (size_t)t * DM) + lane;
#if DBG_STAGE == 0
          const int2 tp = *(const int2*)(P_TOKPOS + 2 * (size_t)t); const float2 tw = *(const float2*)(P_TOKW + 2 * (size_t)t); const float wa = tw.x * (1.f / 32.f), wb = tw.y * (1.f / 32.f);
          const unsigned* ya = (const unsigned*)(P_YB8 + (size_t)tp.x * DM) + lane; const unsigned* yb = (const unsigned*)(P_YB8 + (size_t)tp.y * DM) + lane;
#endif
#pragma unroll
          for (int j = 0; j < 8; ++j) { const u32x2 w = xr[64 * j]; v[j] = (f32x4){bflo(w.x), bfhi(w.x), bflo(w.y), bfhi(w.y)};
#if DBG_STAGE == 0
              const int a = (int)ya[64 * j], b = (int)yb[64 * j];
              const f32x2 a0 = __builtin_amdgcn_cvt_pk_f32_fp8(a, false), a1 = __builtin_amdgcn_cvt_pk_f32_fp8(a, true), b0 = __builtin_amdgcn_cvt_pk_f32_fp8(b, false), b1 = __builtin_amdgcn_cvt_pk_f32_fp8(b, true);
              v[j] += (f32x4){a0[0] * wa + b0[0] * wb, a0[1] * wa + b0[1] * wb, a1[0] * wa + b1[0] * wb, a1[1] * wa + b1[1] * wb};
#endif
          } }
#endif
        float s = 0.f;
#pragma unroll
        for (int j = 0; j < 8; ++j) s += (v[j][0] * v[j][0] + v[j][1] * v[j][1]) + (v[j][2] * v[j][2] + v[j][3] * v[j][3]);
        const float rs = __builtin_amdgcn_rsqf(wave_sum(s) * (1.f / DM) + EPS);
        f32x4* orow = (f32x4*)(ka->out + (size_t)t * DM) + lane;
#pragma unroll
        for (int j = 0; j < 8; ++j) orow[64 * j] = v[j] * rs * fg[j];
    }
#endif
}
}

extern "C" void kernel_launch(void* const* d_in, const int* in_sizes, int n_in, void* d_out, int out_size, void* d_ws, size_t ws_size, hipStream_t stream) {
    static int grid = 0;
    if (grid == 0) {
        if (n_in != 18 || in_sizes[0] != NTOK * DM || out_size != NTOK * DM || ws_size < WS_END) {
            fprintf(stderr, "kernel_launch: unexpected shapes (n_in %d, in0 %d, out %d, ws %zu)\n", n_in, n_in > 0 ? in_sizes[0] : -1, out_size, ws_size); grid = -1; return; }
        int dev = 0, cus = 0;
        if (hipGetDevice(&dev) != hipSuccess || hipDeviceGetAttribute(&cus, hipDeviceAttributeMultiprocessorCount, dev) != hipSuccess) { grid = -1; return; }
        if (hipFuncSetAttribute((const void*)hybrid_fwd, hipFuncAttributeMaxDynamicSharedMemorySize, LDS_BYTES) != hipSuccess) { fprintf(stderr, "kernel_launch: hipFuncSetAttribute failed\n"); grid = -1; return; }
        int per_cu = 0;
        if (hipOccupancyMaxActiveBlocksPerMultiprocessor(&per_cu, (const void*)hybrid_fwd, NWAVES * 64, LDS_BYTES) != hipSuccess || per_cu < 1) { fprintf(stderr, "kernel_launch: occupancy query says %d\n", per_cu); }
        (void)hipGetLastError();
        grid = cus;
    }
    if (grid < 0) return;
    if (hipMemsetAsync((char*)d_ws + WS_CTL, 0, CTL_ZERO_BYTES, stream) != hipSuccess) return;
    Args a{};
    a.x = (const float*)d_in[0]; a.mix_g = (const float*)d_in[1]; a.w_in = (const float*)d_in[2]; a.lq1 = (const float*)d_in[3]; a.lk1 = (const float*)d_in[4];
    a.lq2 = (const float*)d_in[5]; a.lk2 = (const float*)d_in[6]; a.subg = (const float*)d_in[7]; a.w_bsb = (const float*)d_in[8]; a.w_bd = (const float*)d_in[9];
    a.w_out = (const float*)d_in[10]; a.ffn_g = (const float*)d_in[11]; a.w_gr = (const float*)d_in[12]; a.w_er = (const float*)d_in[13]; a.w_gate = (const float*)d_in[14];
    a.w_up = (const float*)d_in[15]; a.w_down = (const float*)d_in[16]; a.fin_g = (const float*)d_in[17];
    a.out = (float*)d_out; a.ws = (unsigned char*)d_ws;
    hipLaunchKernelGGL(hybrid_fwd, dim3(grid), dim3(NWAVES * 64), LDS_BYTES, stream, a);
}
```

```cpp
#include <hip/hip_runtime.h>
#include <cstdio>
#include <cstdint>

#ifndef DBG_STAGE
#define DBG_STAGE 0
#endif

#ifndef PH_MASK
#define PH_MASK 0x3ff
#endif
#define PH(k) ((PH_MASK >> (k)) & 1)
#ifndef REP_LIST
#define REP_LIST 1, 1, 1, 1, 1, 1, 1, 1, 1, 1
#endif
#ifndef REP_SB
#define REP_SB 1
#endif
#ifndef REP_DA
#define REP_DA 1
#endif
constexpr int kReps[10] = {REP_LIST};
#define DI __device__ __forceinline__
#define LAS __attribute__((address_space(3)))
#define GAS __attribute__((address_space(1)))
typedef unsigned short bf16_t;
typedef short bf16x8 __attribute__((ext_vector_type(8)));
typedef short s16x4 __attribute__((ext_vector_type(4)));
typedef float f32x2 __attribute__((ext_vector_type(2)));
typedef float f32x4 __attribute__((ext_vector_type(4)));
typedef float f32x16 __attribute__((ext_vector_type(16)));
typedef unsigned u32x2 __attribute__((ext_vector_type(2)));
typedef unsigned u32x4 __attribute__((ext_vector_type(4)));
typedef int v8i32 __attribute__((ext_vector_type(8)));
typedef int i32x4 __attribute__((ext_vector_type(4)));
typedef __bf16 bf16x2_t __attribute__((ext_vector_type(2)));

constexpr int DM = 2048, NTOK = 16384, SEQ = 2048, INC = 10240, NEXP = 32, DE = 512;
constexpr int PROWS = 40960;
constexpr float EPS = 1e-6f;
constexpr float LOG2E = 1.4426950408889634f;
constexpr float C_SB = LOG2E * 0.08838834764831845f;
constexpr float C_DA = LOG2E * 0.125f;

DI unsigned cvtpk(float lo, float hi) { f32x2 v = {lo, hi}; bf16x2_t b = __builtin_convertvector(v, bf16x2_t); return __builtin_bit_cast(unsigned, b); }
DI unsigned pk4_fp8(float a, float b, float c, float d) { int w = 0; w = __builtin_amdgcn_cvt_pk_fp8_f32(a, b, w, false); w = __builtin_amdgcn_cvt_pk_fp8_f32(c, d, w, true); return (unsigned)w; }
DI float sat8(float v) { return __builtin_amdgcn_fmed3f(v, -448.f, 448.f); }
DI unsigned pk4_fp8_sat(float a, float b, float c, float d) { return pk4_fp8(sat8(a), sat8(b), sat8(c), sat8(d)); }
DI float bf2f(unsigned short b) { return __builtin_bit_cast(float, (unsigned)b << 16); }
DI float bflo(unsigned w) { return __builtin_bit_cast(float, w << 16); }
DI float bfhi(unsigned w) { return __builtin_bit_cast(float, w & 0xffff0000u); }
DI float fexp2(float x) { return __builtin_amdgcn_exp2f(x); }
DI float flog2(float x) { return __builtin_amdgcn_logf(x); }
DI float frcp(float x) { return __builtin_amdgcn_rcpf(x); }
template <int X> DI float swzx(float v) { return __uint_as_float((unsigned)__builtin_amdgcn_ds_swizzle((int)__float_as_uint(v), (X << 10) | 0x1F)); }
DI float half_swap_sum(float v) { auto rr = __builtin_amdgcn_permlane32_swap(__float_as_uint(v), __float_as_uint(v), false, false); return __uint_as_float(rr[0]) + __uint_as_float(rr[1]); }
DI float wave_sum(float v) { v += swzx<1>(v); v += swzx<2>(v); v += swzx<4>(v); v += swzx<8>(v); v += swzx<16>(v); return half_swap_sum(v); }

namespace pg8 {
constexpr int BM = 256, BK = 64, HALF = 128, HTB = HALF * BK * 2, STAGE_BYTES = 8 * HTB, NXCD = 8, WGM = 8;
__host__ __device__ __forceinline__ int lds_byte(int r, int c) { const int c8 = c >> 3; return (r >> 3) * 1024 + (r & 7) * 128 + ((c8 ^ (r & 7)) << 4) + (c & 7) * 2; }
__host__ __device__ __forceinline__ void stage_rc(int b, int& R, int& C) { const int blk = b >> 10, w = (b & 1023) >> 4, r8 = w >> 3, c8 = (w & 7) ^ r8; R = blk * 8 + r8; C = c8 * 8 + (b & 15) / 2; }
__host__ __device__ __forceinline__ int perm32(int rho) { const int n = rho >> 4, i = rho & 15; return 8 * (i >> 2) + 4 * n + (i & 3); }

struct Unit { int pm, pn, bt; };
struct Gemm { const bf16_t* A; const bf16_t* Bt; int M, N, K; };

struct StaticOrder {
    int nM, nN, nwg, G, c;
    __host__ __device__ void init(int M, int N, int G_, int c_) { nM = M / BM; nN = N / BM; nwg = nM * nN; G = G_; c = c_; }
    __host__ __device__ bool next(int i, Unit& u) const {
        const long L = (long)i * G + c; if (L >= nwg) return false;
        int wgid = (int)L; { const int q = nwg / NXCD, r = nwg % NXCD, xcd = wgid % NXCD, off = wgid / NXCD; wgid = (xcd < r ? xcd * (q + 1) : r * (q + 1) + (xcd - r) * q) + off; }
        const int nig = WGM * nN, gid = wgid / nig, fm = gid * WGM, gsz = (nM - fm) < WGM ? (nM - fm) : WGM;
        u.pm = fm + ((wgid % nig) % gsz); u.pn = (wgid % nig) / gsz; u.bt = u.pn; return true;
    }
};
struct MoeOrder {
    const LAS int* tstart; int npn, G, c;
    DI bool next(int i, Unit& u) const {
        const int T = tstart[32], x = c & 7, lo = (T * x) >> 3, hi = (T * (x + 1)) >> 3;
        const int j = i * (G >> 3) + (c >> 3);
        const bool ok = j < (hi - lo) * npn;
        int tile = ok ? lo + j / npn : 0, pn = ok ? j % npn : 0, e = 0;
#pragma unroll
        for (int k = 1; k < 32; ++k) e += (tstart[k] <= tile) ? 1 : 0;
        u.pm = __builtin_amdgcn_readfirstlane(tile); u.pn = __builtin_amdgcn_readfirstlane(pn); u.bt = __builtin_amdgcn_readfirstlane(e * npn + pn);
        return __builtin_amdgcn_readfirstlane((int)ok) != 0;
    }
};

template <class Epi, class Sched, bool ALIGN_EPI, bool SP2>
DI void gemm_phase(LAS unsigned char* lds, const Gemm g, const Sched& S, const Epi& E) {
    int tid = threadIdx.x; asm volatile("" : "+v"(tid));
    const int wid = __builtin_amdgcn_readfirstlane(tid >> 6), lane = tid & 63, wr = wid >> 2, wc = wid & 3, fr = lane & 15, fq = lane >> 4;
    const int K = g.K, nt = K / BK;
    unsigned voffA[2], voffB[2];
#pragma unroll
    for (int i = 0; i < 2; ++i) { int R, C; stage_rc(tid * 16 + i * 8192, R, C); const int Rb = Epi::PERM ? ((R & ~31) + perm32(R & 31)) : R;
        voffA[i] = (unsigned)(R * K + C) * 2u; voffB[i] = (unsigned)(Rb * K + C) * 2u; }
    const size_t kstep = (size_t)(BK * 2);
    const size_t hstep = (size_t)HALF * K * 2;
    const size_t tstep = 2 * hstep;
    const unsigned ldsw = (unsigned)wid * 1024u;
    const int aoff = lds_byte(wr * 64 + fr, fq * 8), boff = lds_byte(wc * 32 + fr, fq * 8), aoff1 = aoff ^ 64, boff1 = boff ^ 64;
#define PG8_SA(b, h) (((b) * 2 + (h)) * HTB)
#define PG8_SB(b, h) ((4 + (b) * 2 + (h)) * HTB)
#define PG8_STAGE(bufoff, gbase, voff) do { _Pragma("unroll") for (int _i = 0; _i < 2; ++_i) \
        __builtin_amdgcn_global_load_lds((const unsigned*)((const char*)(gbase) + (voff)[_i]), (LAS unsigned*)(lds + (bufoff) + ldsw + _i * 8192), 16, 0, 0); } while (0)
#define PG8_LDA(dst, b, h) do { _Pragma("unroll") for (int m = 0; m < 4; ++m) _Pragma("unroll") for (int k = 0; k < 2; ++k) dst[m][k] = *(const LAS bf16x8*)(lds + PG8_SA(b, h) + (k ? aoff1 : aoff) + m * 2048); } while (0)
#define PG8_LDB(dst, b, h) do { _Pragma("unroll") for (int n = 0; n < 2; ++n) _Pragma("unroll") for (int k = 0; k < 2; ++k) dst[n][k] = *(const LAS bf16x8*)(lds + PG8_SB(b, h) + (k ? boff1 : boff) + n * 2048); } while (0)
#define PG8_MMA(ai, bj, At, Bt) do { __builtin_amdgcn_s_setprio(1); _Pragma("unroll") for (int m = 0; m < 4; ++m) _Pragma("unroll") for (int n = 0; n < 2; ++n) _Pragma("unroll") for (int k = 0; k < 2; ++k) \
        acc[ai][bj][m][n] = __builtin_amdgcn_mfma_f32_16x16x32_bf16(Bt[n][k], At[m][k], acc[ai][bj][m][n], 0, 0, 0); __builtin_amdgcn_s_setprio(0); } while (0)
#define PG8_WAIT_V(n) asm volatile("s_waitcnt vmcnt(" #n ")" ::: "memory")
#define PG8_WAIT_L(n) asm volatile("s_waitcnt lgkmcnt(" #n ")" ::: "memory")
#define PG8_BAR __builtin_amdgcn_s_barrier()
#define PG8_SCHED __builtin_amdgcn_sched_barrier(0)
    Unit cur, nxt; int ui = 0;
    if (!S.next(0, cur)) return;
    f32x4 acc[2][2][4][2];
#pragma unroll
    for (int a = 0; a < 2; ++a)
#pragma unroll
        for (int b = 0; b < 2; ++b)
#pragma unroll
            for (int m = 0; m < 4; ++m)
#pragma unroll
                for (int n = 0; n < 2; ++n) acc[a][b][m][n] = (f32x4){0.f, 0.f, 0.f, 0.f};
    bf16x8 At[4][2], B0[2][2], B1[2][2];
    const char* cA = (const char*)g.A + (size_t)cur.pm * tstep; const char* cB = (const char*)g.Bt + (size_t)cur.bt * tstep;
    if constexpr (SP2) {
        PG8_STAGE(PG8_SB(0, 0), cB, voffB); PG8_STAGE(PG8_SB(0, 1), cB + hstep, voffB); PG8_STAGE(PG8_SA(0, 0), cA, voffA); PG8_STAGE(PG8_SA(0, 1), cA + hstep, voffA);
        if (wr == 1) PG8_BAR;
        PG8_WAIT_V(2); PG8_BAR;
        PG8_STAGE(PG8_SB(1, 0), cB + kstep, voffB); PG8_STAGE(PG8_SA(1, 0), cA + kstep, voffA); PG8_STAGE(PG8_SB(1, 1), cB + hstep + kstep, voffB);
        PG8_WAIT_V(6); PG8_BAR;
    } else {
        PG8_STAGE(PG8_SB(0, 0), cB, voffB); PG8_STAGE(PG8_SA(0, 0), cA, voffA); PG8_STAGE(PG8_SB(0, 1), cB + hstep, voffB); PG8_STAGE(PG8_SA(0, 1), cA + hstep, voffA);
        if (wr == 1) PG8_BAR;
        PG8_WAIT_V(4); PG8_BAR;
        PG8_STAGE(PG8_SB(1, 0), cB + kstep, voffB); PG8_STAGE(PG8_SA(1, 0), cA + kstep, voffA); PG8_STAGE(PG8_SB(1, 1), cB + hstep + kstep, voffB);
        PG8_WAIT_V(6); PG8_BAR;
    }
    for (;;) {
        const bool has_next = S.next(ui + 1, nxt);
        const char* nA = has_next ? (const char*)g.A + (size_t)nxt.pm * tstep : cA; const char* nB = has_next ? (const char*)g.Bt + (size_t)nxt.bt * tstep : cB;
        for (int t = 0; t < nt; t += 2) {
            const bool last = (t == nt - 2);
            const char* a1 = cA + (size_t)(t + 1) * kstep;
            const char* a2 = last ? nA : cA + (size_t)(t + 2) * kstep; const char* b2 = last ? nB : cB + (size_t)(t + 2) * kstep;
            const char* a3 = a2 + kstep; const char* b3 = b2 + kstep;
            if constexpr (Epi::HAS_MID) { if (t == Epi::MID_T) E.mid(acc, cur, wr, wc, fr, fq); }
            if constexpr (SP2) {
            PG8_LDB(B0, 0, 0); PG8_LDB(B1, 0, 1); PG8_SCHED; PG8_LDA(At, 0, 0); PG8_STAGE(PG8_SA(1, 1), a1 + hstep, voffA);
            PG8_WAIT_V(8); PG8_WAIT_L(0); PG8_BAR; PG8_MMA(0, 0, At, B0); PG8_MMA(0, 1, At, B1); PG8_BAR; PG8_SCHED;
            PG8_LDA(At, 0, 1); PG8_STAGE(PG8_SB(0, 0), b2, voffB); PG8_STAGE(PG8_SB(0, 1), b2 + hstep, voffB); PG8_STAGE(PG8_SA(0, 0), a2, voffA);
            PG8_WAIT_V(8); PG8_WAIT_L(0); PG8_BAR; PG8_MMA(1, 0, At, B0); PG8_MMA(1, 1, At, B1); PG8_BAR; PG8_SCHED;
            PG8_LDB(B0, 1, 0); PG8_LDB(B1, 1, 1); PG8_SCHED; PG8_LDA(At, 1, 0); PG8_STAGE(PG8_SA(0, 1), a2 + hstep, voffA);
            PG8_WAIT_V(8); PG8_WAIT_L(0); PG8_BAR; PG8_MMA(0, 0, At, B0); PG8_MMA(0, 1, At, B1); PG8_BAR; PG8_SCHED;
            PG8_LDA(At, 1, 1); PG8_STAGE(PG8_SB(1, 0), b3, voffB); PG8_STAGE(PG8_SB(1, 1), b3 + hstep, voffB); PG8_STAGE(PG8_SA(1, 0), a3, voffA);
            PG8_WAIT_V(8); PG8_WAIT_L(0); PG8_BAR; PG8_MMA(1, 0, At, B0); PG8_MMA(1, 1, At, B1); PG8_BAR; PG8_SCHED;
            } else {
            PG8_LDB(B0, 0, 0); PG8_SCHED; PG8_LDA(At, 0, 0); PG8_STAGE(PG8_SA(1, 1), a1 + hstep, voffA);
            PG8_WAIT_L(8); PG8_BAR; PG8_WAIT_L(0); PG8_MMA(0, 0, At, B0); PG8_BAR; PG8_SCHED;
            PG8_LDB(B1, 0, 1); PG8_STAGE(PG8_SB(0, 0), b2, voffB);
            PG8_BAR; PG8_WAIT_L(0); PG8_MMA(0, 1, At, B1); PG8_BAR;
            PG8_LDA(At, 0, 1); PG8_STAGE(PG8_SA(0, 0), a2, voffA);
            PG8_BAR; PG8_WAIT_L(0); PG8_MMA(1, 0, At, B0); PG8_BAR; PG8_SCHED;
            PG8_STAGE(PG8_SB(0, 1), b2 + hstep, voffB);
            PG8_WAIT_V(6); PG8_BAR; PG8_MMA(1, 1, At, B1); PG8_BAR;
            PG8_LDB(B0, 1, 0); PG8_SCHED; PG8_LDA(At, 1, 0); PG8_STAGE(PG8_SA(0, 1), a2 + hstep, voffA);
            PG8_WAIT_L(8); PG8_BAR; PG8_WAIT_L(0); PG8_MMA(0, 0, At, B0); PG8_BAR; PG8_SCHED;
            PG8_LDB(B1, 1, 1); PG8_STAGE(PG8_SB(1, 0), b3, voffB);
            PG8_BAR; PG8_WAIT_L(0); PG8_MMA(0, 1, At, B1); PG8_BAR;
            PG8_LDA(At, 1, 1); PG8_STAGE(PG8_SA(1, 0), a3, voffA);
            PG8_BAR; PG8_WAIT_L(0); PG8_MMA(1, 0, At, B0); PG8_BAR; PG8_SCHED;
            PG8_STAGE(PG8_SB(1, 1), b3 + hstep, voffB);
            PG8_WAIT_V(6); PG8_BAR; PG8_MMA(1, 1, At, B1); PG8_BAR;
            }
        }
        if constexpr (ALIGN_EPI) { if (wr == 0) PG8_BAR; }
        E(acc, cur, wr, wc, fr, fq);
        if (!has_next) break;
#pragma unroll
        for (int a = 0; a < 2; ++a)
#pragma unroll
            for (int b = 0; b < 2; ++b)
#pragma unroll
                for (int m = 0; m < 4; ++m)
#pragma unroll
                    for (int n = 0; n < 2; ++n) acc[a][b][m][n] = (f32x4){0.f, 0.f, 0.f, 0.f};
        cur = nxt; cA = nA; cB = nB; ++ui;
        if constexpr (ALIGN_EPI) { if (wr == 1) PG8_BAR; }
    }
    PG8_WAIT_V(0);
    if constexpr (!ALIGN_EPI) { if (wr == 0) PG8_BAR; }
    PG8_BAR;
#undef PG8_SA
#undef PG8_SB
#undef PG8_STAGE
#undef PG8_LDA
#undef PG8_LDB
#undef PG8_MMA
#undef PG8_WAIT_V
#undef PG8_WAIT_L
#undef PG8_BAR
#undef PG8_SCHED
}

typedef f32x4 AccN[2][4][2];
template <class Epi, class Sched, int SCW, int SCX>
DI void gemm_f8_phase(LAS unsigned char* lds, const Gemm g, const Sched& S, const Epi& E) {
    int tid = threadIdx.x; asm volatile("" : "+v"(tid));
    const int wid = __builtin_amdgcn_readfirstlane(tid >> 6), lane = tid & 63, wr = wid >> 2, wc = wid & 3, fr = lane & 15, fq = lane >> 4;
    const int K = g.K, nt = K / BK;
    unsigned voffA[2], voffB[2];
#pragma unroll
    for (int i = 0; i < 2; ++i) { int R, C; stage_rc(tid * 16 + i * 8192, R, C); const int Rb = (R & ~31) + perm32(R & 31);
        voffA[i] = (unsigned)(R * K + C) * 2u; voffB[i] = (unsigned)(Rb * K + C) * 2u; }
    const size_t kstep = (size_t)(BK * 2);
    const size_t hstep = (size_t)HALF * K * 2;
    const size_t tstep = 2 * hstep;
    const unsigned ldsw = (unsigned)wid * 1024u;
    const int aoff = lds_byte(wr * 64 + fr, fq * 8), boff = lds_byte(wc * 32 + fr, fq * 8), aoff1 = aoff ^ 64, boff1 = boff ^ 64;
    const int scw = SCW * 0x01010101, scx = SCX * 0x01010101;
#define PG8_SA(b, h) (((b) * 2 + (h)) * HTB)
#define PG8_SB(b, h) ((4 + (b) * 2 + (h)) * HTB)
#define PG8_STAGE(bufoff, gbase, voff) do { _Pragma("unroll") for (int _i = 0; _i < 2; ++_i) \
        __builtin_amdgcn_global_load_lds((const unsigned*)((const char*)(gbase) + (voff)[_i]), (LAS unsigned*)(lds + (bufoff) + ldsw + _i * 8192), 16, 0, 0); } while (0)
#define PG8_LD16(off) (*(const LAS i32x4*)(lds + (off)))
#define PG8_LDA8(dst, b, h) do { _Pragma("unroll") for (int m = 0; m < 4; ++m) dst[m] = __builtin_shufflevector(PG8_LD16(PG8_SA(b, h) + aoff + m * 2048), PG8_LD16(PG8_SA(b, h) + aoff1 + m * 2048), 0, 1, 2, 3, 4, 5, 6, 7); } while (0)
#define PG8_LDB8(dst, b) do { _Pragma("unroll") for (int n = 0; n < 2; ++n) dst[n] = __builtin_shufflevector(PG8_LD16(PG8_SB(b, 0) + boff + n * 2048), PG8_LD16(PG8_SB(b, 0) + boff1 + n * 2048), 0, 1, 2, 3, 4, 5, 6, 7); } while (0)
#define PG8_MMA8(ai) do { __builtin_amdgcn_s_setprio(1); _Pragma("unroll") for (int m = 0; m < 4; ++m) _Pragma("unroll") for (int n = 0; n < 2; ++n) \
        acc[ai][m][n] = __builtin_amdgcn_mfma_scale_f32_16x16x128_f8f6f4(B08[n], At8[m], acc[ai][m][n], 0, 0, 0, scw, 0, scx); __builtin_amdgcn_s_setprio(0); } while (0)
#define PG8_WAIT_V(n) asm volatile("s_waitcnt vmcnt(" #n ")" ::: "memory")
#define PG8_WAIT_L(n) asm volatile("s_waitcnt lgkmcnt(" #n ")" ::: "memory")
#define PG8_BAR __builtin_amdgcn_s_barrier()
#define PG8_SCHED __builtin_amdgcn_sched_barrier(0)
    Unit cur, nxt; int ui = 0;
    if (!S.next(0, cur)) return;
    f32x4 acc[2][4][2];
#pragma unroll
    for (int a = 0; a < 2; ++a)
#pragma unroll
        for (int m = 0; m < 4; ++m)
#pragma unroll
            for (int n = 0; n < 2; ++n) acc[a][m][n] = (f32x4){0.f, 0.f, 0.f, 0.f};
    v8i32 At8[4], B08[2];
    const char* cA = (const char*)g.A + (size_t)cur.pm * tstep; const char* cB = (const char*)g.Bt + (size_t)cur.bt * hstep;
    PG8_STAGE(PG8_SB(0, 0), cB, voffB); PG8_STAGE(PG8_SA(0, 0), cA, voffA); PG8_STAGE(PG8_SA(0, 1), cA + hstep, voffA);
    if (wr == 1) PG8_BAR;
    PG8_WAIT_V(2); PG8_BAR;
    PG8_STAGE(PG8_SB(1, 0), cB + kstep, voffB); PG8_STAGE(PG8_SA(1, 0), cA + kstep, voffA);
    PG8_WAIT_V(4); PG8_BAR;
    for (;;) {
        const bool has_next = S.next(ui + 1, nxt);
        const char* nA = has_next ? (const char*)g.A + (size_t)nxt.pm * tstep : cA; const char* nB = has_next ? (const char*)g.Bt + (size_t)nxt.bt * hstep : cB;
#pragma unroll 1
        for (int t = 0; t < nt; t += 2) {
            const bool last = (t == nt - 2);
            const char* a1 = cA + (size_t)(t + 1) * kstep;
            const char* a2 = last ? nA : cA + (size_t)(t + 2) * kstep; const char* b2 = last ? nB : cB + (size_t)(t + 2) * kstep;
            const char* a3 = a2 + kstep; const char* b3 = b2 + kstep;
            PG8_LDB8(B08, 0); PG8_SCHED; PG8_LDA8(At8, 0, 0); PG8_STAGE(PG8_SA(1, 1), a1 + hstep, voffA);
            PG8_WAIT_V(6); PG8_WAIT_L(0); PG8_BAR; PG8_MMA8(0); PG8_BAR; PG8_SCHED;
            PG8_LDA8(At8, 0, 1); PG8_STAGE(PG8_SB(0, 0), b2, voffB); PG8_STAGE(PG8_SA(0, 0), a2, voffA);
            PG8_WAIT_V(6); PG8_WAIT_L(0); PG8_BAR; PG8_MMA8(1); PG8_BAR; PG8_SCHED;
            PG8_LDB8(B08, 1); PG8_SCHED; PG8_LDA8(At8, 1, 0); PG8_STAGE(PG8_SA(0, 1), a2 + hstep, voffA);
            PG8_WAIT_V(6); PG8_WAIT_L(0); PG8_BAR; PG8_MMA8(0); PG8_BAR; PG8_SCHED;
            PG8_LDA8(At8, 1, 1); PG8_STAGE(PG8_SB(1, 0), b3, voffB); PG8_STAGE(PG8_SA(1, 0), a3, voffA);
            PG8_WAIT_V(6); PG8_WAIT_L(0); PG8_BAR; PG8_MMA8(1); PG8_BAR; PG8_SCHED;
        }
        if (wr == 0) PG8_BAR;
        E(acc, cur, wr, wc, fr, fq);
        if (!has_next) break;
#pragma unroll
        for (int a = 0; a < 2; ++a)
#pragma unroll
            for (int m = 0; m < 4; ++m)
#pragma unroll
                for (int n = 0; n < 2; ++n) acc[a][m][n] = (f32x4){0.f, 0.f, 0.f, 0.f};
        cur = nxt; cA = nA; cB = nB; ++ui;
        if (wr == 1) PG8_BAR;
    }
    PG8_WAIT_V(0);
    PG8_BAR;
#undef PG8_SA
#undef PG8_SB
#undef PG8_STAGE
#undef PG8_LD16
#undef PG8_LDA8
#undef PG8_LDB8
#undef PG8_MMA8
#undef PG8_WAIT_V
#undef PG8_WAIT_L
#undef PG8_BAR
#undef PG8_SCHED
}

typedef f32x4 AccQ[4][4];
template <class Epi, class Sched, int SCW, int SCX, int FMT = 0  >
DI void gemm_f8v2_phase(LAS unsigned char* lds, const Gemm g, const Sched& S, const Epi& E) {
    int tid = threadIdx.x; asm volatile("" : "+v"(tid));
    const int wid = __builtin_amdgcn_readfirstlane(tid >> 6), lane = tid & 63, wr4 = wid >> 1, wc2 = wid & 1, fr = lane & 15, fq = lane >> 4;
    const int K = g.K, nt = K / BK;
    unsigned voffA[2], voffB[2];
#pragma unroll
    for (int i = 0; i < 2; ++i) { int R, C; stage_rc(tid * 16 + i * 8192, R, C); const int Rb = (R & ~31) + perm32(R & 31);
        voffA[i] = (unsigned)(R * K + C) * 2u; voffB[i] = (unsigned)(Rb * K + C) * 2u; }
    const size_t kstep = (size_t)(BK * 2);
    const size_t hstep = (size_t)HALF * K * 2;
    const size_t tstep = 2 * hstep;
    const unsigned ldsw = (unsigned)wid * 1024u;
    constexpr int BUFB = 3 * HTB;
    const int aoff = (wr4 >> 1) * HTB + lds_byte((wr4 & 1) * 64 + fr, fq * 8), boff = 2 * HTB + lds_byte(wc2 * 64 + fr, fq * 8);
    const int scw = SCW * 0x01010101, scx = SCX * 0x01010101;
#define F8_STAGE(ldsoff, gbase, voff) do { _Pragma("unroll") for (int _i = 0; _i < 2; ++_i) \
        __builtin_amdgcn_global_load_lds((const unsigned*)((const char*)(gbase) + (voff)[_i]), (LAS unsigned*)(lds + (ldsoff) + ldsw + _i * 8192), 16, 0, 0); } while (0)
#define F8_STAGE3(bufoff, pa, pb) do { F8_STAGE((bufoff), (pa), voffA); F8_STAGE((bufoff) + HTB, (pa) + hstep, voffA); F8_STAGE((bufoff) + 2 * HTB, (pb), voffB); } while (0)
#define F8_LD16(off) (*(const LAS i32x4*)(lds + (off)))
#define F8_LDF(dst, base, k) dst = __builtin_shufflevector(F8_LD16((base) + (k) * 2048), F8_LD16(((base) ^ 64) + (k) * 2048), 0, 1, 2, 3, 4, 5, 6, 7)
#define F8_MMA(CA, CB, m, q) acc[m][q] = __builtin_amdgcn_mfma_scale_f32_16x16x128_f8f6f4(CB[q], CA[m], acc[m][q], FMT, FMT, 0, scw, 0, scx)
#define F8_WAIT_V(n) asm volatile("s_waitcnt vmcnt(" #n ")" ::: "memory")
#define F8_WAIT_L(n) asm volatile("s_waitcnt lgkmcnt(" #n ")" ::: "memory")
#define F8_SCHED __builtin_amdgcn_sched_barrier(0)
#define F8_PIN(m) asm volatile("" : "+v"(acc[m][0]), "+v"(acc[m][1]), "+v"(acc[m][2]), "+v"(acc[m][3]))
#define F8_PIECE(ldsoff, gbase, voff, i) __builtin_amdgcn_global_load_lds((const unsigned*)((const char*)(gbase) + (voff)[i]), (LAS unsigned*)(lds + (ldsoff) + ldsw + (i) * 8192), 16, 0, 0)
#define F8_TILE(CA, CB, NA, NB) do { \
        F8_WAIT_L(0); F8_SCHED; __builtin_amdgcn_s_setprio(1); \
          \
        F8_MMA(CA, CB, 0, 0); F8_MMA(CA, CB, 0, 1); F8_MMA(CA, CB, 0, 2); F8_MMA(CA, CB, 0, 3); F8_SCHED; \
        F8_WAIT_V(6); __builtin_amdgcn_s_barrier(); \
        { const bool w_ = (dt == nt); dA = w_ ? nA : dA; dB = w_ ? nB : dB; dt = w_ ? 0 : dt; } \
        { const int db_ = bufc * BUFB; bufc = (bufc == 2) ? 0 : bufc + 1; const int ra_ = aoff + bufc * BUFB, rb_ = boff + bufc * BUFB; F8_SCHED; \
            \
          F8_MMA(CA, CB, 1, 0); F8_MMA(CA, CB, 1, 1); F8_LDF(NB[0], rb_, 0); F8_LDF(NA[0], ra_, 0); F8_SCHED; F8_MMA(CA, CB, 1, 2); F8_MMA(CA, CB, 1, 3); F8_LDF(NB[1], rb_, 1); F8_LDF(NB[2], rb_, 2); F8_SCHED; \
          F8_MMA(CA, CB, 2, 0); F8_MMA(CA, CB, 2, 1); F8_LDF(NB[3], rb_, 3); F8_LDF(NA[1], ra_, 1); F8_PIECE(db_, dA, voffA, 0); F8_SCHED; F8_MMA(CA, CB, 2, 2); F8_MMA(CA, CB, 2, 3); F8_LDF(NA[2], ra_, 2); F8_LDF(NA[3], ra_, 3); F8_PIECE(db_, dA, voffA, 1); F8_SCHED; \
          F8_MMA(CA, CB, 3, 0); F8_MMA(CA, CB, 3, 1); F8_PIECE(db_ + HTB, dA + hstep, voffA, 0); F8_PIECE(db_ + HTB, dA + hstep, voffA, 1); F8_SCHED; F8_MMA(CA, CB, 3, 2); F8_MMA(CA, CB, 3, 3); F8_PIECE(db_ + 2 * HTB, dB, voffB, 0); F8_PIECE(db_ + 2 * HTB, dB, voffB, 1); F8_SCHED; \
          __builtin_amdgcn_s_setprio(0); F8_PIN(0); F8_PIN(1); F8_PIN(2); F8_PIN(3); } \
        dA += kstep; dB += kstep; ++dt; \
    } while (0)
    Unit cur, nxt; int ui = 0;
    if (!S.next(0, cur)) return;
    f32x4 acc[4][4];
#pragma unroll
    for (int m = 0; m < 4; ++m)
#pragma unroll
        for (int q = 0; q < 4; ++q) acc[m][q] = (f32x4){0.f, 0.f, 0.f, 0.f};
    v8i32 A0[4], B0[4], A1[4], B1[4];
    const char* cA = (const char*)g.A + (size_t)cur.pm * tstep; const char* cB = (const char*)g.Bt + (size_t)cur.bt * hstep;
    int bufc = 0, dt = 3;
    F8_STAGE3(0, cA, cB); F8_STAGE3(BUFB, cA + kstep, cB + kstep); F8_STAGE3(2 * BUFB, cA + 2 * kstep, cB + 2 * kstep);
    const char* dA = cA + 3 * kstep; const char* dB = cB + 3 * kstep;
    F8_WAIT_V(12); __builtin_amdgcn_s_barrier();
#pragma unroll
    for (int k = 0; k < 4; ++k) { F8_LDF(B0[k], boff, k); F8_LDF(A0[k], aoff, k); }
    for (;;) {
        const bool has_next = S.next(ui + 1, nxt);
        const char* nA = has_next ? (const char*)g.A + (size_t)nxt.pm * tstep : cA; const char* nB = has_next ? (const char*)g.Bt + (size_t)nxt.bt * hstep : cB;
#pragma unroll 1
        for (int t = 0; t < nt; t += 2) {
            F8_TILE(A0, B0, A1, B1);
            F8_TILE(A1, B1, A0, B0);
        }
        E(acc, cur, wr4, wc2, fr, fq);
        if (!has_next) break;
#pragma unroll
        for (int m = 0; m < 4; ++m)
#pragma unroll
            for (int q = 0; q < 4; ++q) acc[m][q] = (f32x4){0.f, 0.f, 0.f, 0.f};
        cur = nxt; cA = nA; cB = nB; ++ui;
    }
    F8_WAIT_V(0); F8_WAIT_L(0);
    __builtin_amdgcn_s_barrier();
#undef F8_STAGE
#undef F8_STAGE3
#undef F8_LD16
#undef F8_LDF
#undef F8_MMA
#undef F8_WAIT_V
#undef F8_WAIT_L
#undef F8_SCHED
#undef F8_TILE
#undef F8_PIECE
#undef F8_PIN
}

typedef f32x4 Acc[2][2][4][2];
DI u32x4 pack8(const f32x4 a, const f32x4 b) { u32x4 w; w.x = cvtpk(a[0], a[1]); w.y = cvtpk(a[2], a[3]); w.z = cvtpk(b[0], b[1]); w.w = cvtpk(b[2], b[3]); return w; }

struct EpiInProj {
    static constexpr bool PERM = true, HAS_MID = false; static constexpr int MID_T = 0;
    bf16_t* qkv;
    const f32x2* rope;
    DI void mid(Acc&, const Unit&, int, int, int, int) const {}
    DI void operator()(Acc& acc, const Unit& u, int wr, int wc, int fr, int fq) const {
 asm volatile("" : "+v"(fr), "+v"(fq));
               const int pn = u.pn, row0 = u.pm * BM + wr * 64 + fr;
        if (pn >= 12 && pn < 20) {
            const int tsel = (pn < 16) ? 3 : 4; const float sc = (pn < 16) ? C_DA : 1.f;
            bf16_t* dst = qkv + (size_t)tsel * NTOK * 1024; const int col0 = ((pn - 12) & 3) * 256 + wc * 64 + 8 * fq;
            f32x4 st[4], cs0[4], cs1[4];
            { const f32x4* sp = (const f32x4*)(rope + (size_t)16 * 32 + 8 * fq); const f32x4* p0 = (const f32x4*)(rope + (size_t)(row0 & (SEQ - 1)) * 32 + 8 * fq);
              const f32x4* p1 = (const f32x4*)(rope + (size_t)((row0 + HALF) & (SEQ - 1)) * 32 + 8 * fq);
#pragma unroll
              for (int k = 0; k < 4; ++k) { st[k] = sp[k]; cs0[k] = p0[k]; cs1[k] = p1[k]; } }
#pragma unroll
            for (int ai = 0; ai < 2; ++ai) { f32x4 cs[4];
#pragma unroll
                for (int k = 0; k < 4; ++k) cs[k] = ai ? cs1[k] : cs0[k];
#pragma unroll
                for (int m = 0; m < 4; ++m) {
                    if (m > 0) {
#pragma unroll
                        for (int k = 0; k < 4; ++k) { const f32x4 c = cs[k], d = st[k];
                            cs[k] = (f32x4){c[0] * d[0] - c[1] * d[1], c[1] * d[0] + c[0] * d[1], c[2] * d[2] - c[3] * d[3], c[3] * d[2] + c[2] * d[3]}; } }
#pragma unroll
                    for (int n = 0; n < 2; ++n) { const f32x4 c0 = cs[2 * n], c1 = cs[2 * n + 1]; const f32x4 xl = acc[ai][0][m][n], xh = acc[ai][1][m][n];
                        const float co[4] = {c0[0], c0[2], c1[0], c1[2]}, si[4] = {c0[1], c0[3], c1[1], c1[3]};
#pragma unroll
                        for (int j = 0; j < 4; ++j) { acc[ai][0][m][n][j] = (xl[j] * co[j] - xh[j] * si[j]) * sc; acc[ai][1][m][n][j] = (xh[j] * co[j] + xl[j] * si[j]) * sc; } }
                    bf16_t* rowp = dst + (size_t)(row0 + ai * HALF + m * 16) * 1024 + col0;
                    __builtin_nontemporal_store(pack8(acc[ai][0][m][0], acc[ai][0][m][1]), (u32x4*)(rowp)); __builtin_nontemporal_store(pack8(acc[ai][1][m][0], acc[ai][1][m][1]), (u32x4*)(rowp + 32)); } }
        } else {
            const int tsel = (pn < 12) ? (pn >> 2) : 5; const float sc = (pn < 4) ? C_SB : 1.f;
            bf16_t* dst = qkv + (size_t)tsel * NTOK * 1024; const int col0 = (pn & 3) * 256 + wc * 32 + 8 * fq;
#pragma unroll
            for (int ai = 0; ai < 2; ++ai)
#pragma unroll
                for (int m = 0; m < 4; ++m) { bf16_t* rowp = dst + (size_t)(row0 + ai * HALF + m * 16) * 1024 + col0;
#pragma unroll
                    for (int bj = 0; bj < 2; ++bj) __builtin_nontemporal_store(pack8(acc[ai][bj][m][0] * sc, acc[ai][bj][m][1] * sc), (u32x4*)(rowp + bj * HALF)); }
        }
    }
};

struct EpiMerged {
    static constexpr bool PERM = true, HAS_MID = true; static constexpr int MID_T = 16;
    const bf16_t* gsb; const bf16_t* gda; bf16_t* merged;
    DI void mid(Acc& acc, const Unit& u, int wr, int wc, int fr, int fq) const {
        asm volatile("" : "+v"(fr), "+v"(fq));
        const int row0 = u.pm * BM + wr * 64 + fr, col0 = u.pn * BM + wc * 32 + 8 * fq;
        u32x4 a[2][4][2];
#pragma unroll
        for (int ai = 0; ai < 2; ++ai)
#pragma unroll
            for (int m = 0; m < 4; ++m) { const size_t off = (size_t)(row0 + ai * HALF + m * 16) * 2048 + col0;
#pragma unroll
                for (int bj = 0; bj < 2; ++bj) a[ai][m][bj] = __builtin_nontemporal_load((const u32x4*)(gsb + off + bj * HALF)); }
        asm volatile("" ::: "memory");
#pragma unroll
        for (int ai = 0; ai < 2; ++ai)
#pragma unroll
            for (int m = 0; m < 4; ++m)
#pragma unroll
                for (int bj = 0; bj < 2; ++bj)
#pragma unroll
                    for (int w = 0; w < 4; ++w) { acc[ai][bj][m][w >> 1][(w & 1) * 2] *= bflo(a[ai][m][bj][w]); acc[ai][bj][m][w >> 1][(w & 1) * 2 + 1] *= bfhi(a[ai][m][bj][w]); }
        asm volatile("" ::: "memory");
    }
    DI void operator()(Acc& acc, const Unit& u, int wr, int wc, int fr, int fq) const {
        asm volatile("" : "+v"(fr), "+v"(fq));
        const int row0 = u.pm * BM + wr * 64 + fr, col0 = u.pn * BM + wc * 32 + 8 * fq;
        u32x4 b[2][4][2];
#pragma unroll
        for (int ai = 0; ai < 2; ++ai)
#pragma unroll
            for (int m = 0; m < 4; ++m) { const size_t off = (size_t)(row0 + ai * HALF + m * 16) * 2048 + col0;
#pragma unroll
                for (int bj = 0; bj < 2; ++bj) b[ai][m][bj] = __builtin_nontemporal_load((const u32x4*)(gda + off + bj * HALF)); }
        asm volatile("" ::: "memory");
#pragma unroll
        for (int ai = 0; ai < 2; ++ai)
#pragma unroll
            for (int m = 0; m < 4; ++m) { const size_t off = (size_t)(row0 + ai * HALF + m * 16) * 2048 + col0;
#pragma unroll
                for (int bj = 0; bj < 2; ++bj) { const u32x4 g = b[ai][m][bj]; f32x4 v0 = acc[ai][bj][m][0], v1 = acc[ai][bj][m][1];
                    v0[0] *= bflo(g[0]); v0[1] *= bfhi(g[0]); v0[2] *= bflo(g[1]); v0[3] *= bfhi(g[1]); v1[0] *= bflo(g[2]); v1[1] *= bfhi(g[2]); v1[2] *= bflo(g[3]); v1[3] *= bfhi(g[3]);
                    *(u32x4*)(merged + off + bj * HALF) = pack8(v0, v1); } }
    }
};

struct EpiX1 {
    static constexpr bool PERM = true, HAS_MID = false; static constexpr int MID_T = 0;
    const float* x; bf16_t* x1b; float* ssq;
    DI void mid(Acc&, const Unit&, int, int, int, int) const {}
    DI void operator()(Acc& acc, const Unit& u, int wr, int wc, int fr, int fq) const {
        asm volatile("" : "+v"(fr), "+v"(fq));
        const int row0 = u.pm * BM + wr * 64 + fr, col0 = u.pn * BM + wc * 32 + 8 * fq;
        float sq[2][4];
#pragma unroll
        for (int ai = 0; ai < 2; ++ai) { f32x4 xv[4][2][2];
#pragma unroll
            for (int m = 0; m < 4; ++m) { const size_t off = (size_t)(row0 + ai * HALF + m * 16) * 2048 + col0;
#pragma unroll
                for (int bj = 0; bj < 2; ++bj) { xv[m][bj][0] = __builtin_nontemporal_load((const f32x4*)(x + off + bj * HALF)); xv[m][bj][1] = __builtin_nontemporal_load((const f32x4*)(x + off + bj * HALF + 4)); } }
            asm volatile("" ::: "memory");
#pragma unroll
            for (int m = 0; m < 4; ++m) { float s = 0.f;
#pragma unroll
                for (int bj = 0; bj < 2; ++bj) { const f32x4 v0 = acc[ai][bj][m][0] + xv[m][bj][0], v1 = acc[ai][bj][m][1] + xv[m][bj][1]; acc[ai][bj][m][0] = v0; acc[ai][bj][m][1] = v1;
                    s += (v0[0] * v0[0] + v0[1] * v0[1]) + (v0[2] * v0[2] + v0[3] * v0[3]) + (v1[0] * v1[0] + v1[1] * v1[1]) + (v1[2] * v1[2] + v1[3] * v1[3]); }
                s += swzx<16>(s); s = half_swap_sum(s); sq[ai][m] = s; }
            asm volatile("" ::: "memory"); }
#pragma unroll
        for (int ai = 0; ai < 2; ++ai)
#pragma unroll
            for (int m = 0; m < 4; ++m) { const int row = row0 + ai * HALF + m * 16; const size_t off = (size_t)row * 2048 + col0;
#pragma unroll
                for (int bj = 0; bj < 2; ++bj) *(u32x4*)(x1b + off + bj * HALF) = pack8(acc[ai][bj][m][0], acc[ai][bj][m][1]);
                if (fq == 0) ssq[(size_t)row * 32 + u.pn * 4 + wc] = sq[ai][m]; }
    }
};

struct EpiSwiglu2 {
    static constexpr int NST = 8;
    unsigned char* H;
    DI void operator()(AccQ& acc, const Unit& u, int wr4, int wc2, int fr, int fq) const {
        asm volatile("" : "+v"(fr), "+v"(fq));
        const int row0 = u.pm * BM + wr4 * 64 + fr, col0 = u.pn * 64 + wc2 * 32 + 4 * fq;
#pragma unroll
        for (int c2 = 0; c2 < 2; ++c2)
#pragma unroll
            for (int m = 0; m < 4; ++m) { float h[4];
#pragma unroll
                for (int j = 0; j < 4; ++j) { const float gt = acc[m][2 * c2][j], up = acc[m][2 * c2 + 1][j]; h[j] = gt * up * frcp(1.f + fexp2(-LOG2E * gt)); }
                *(unsigned*)(H + (size_t)(row0 + m * 16) * DE + col0 + 16 * c2) = pk4_fp8_sat(h[0], h[1], h[2], h[3]); }
    }
};
struct EpiGate2 {
    bf16_t* gsb; bf16_t* gda;
    DI void operator()(AccQ& acc, const Unit& u, int wr4, int wc2, int fr, int fq) const {
        asm volatile("" : "+v"(fr), "+v"(fq));
        const int row0 = u.pm * BM + wr4 * 64 + fr, col0 = u.pn * 64 + wc2 * 32 + 8 * fq;
#pragma unroll
        for (int m = 0; m < 4; ++m) { f32x4 r0, r1, d0, d1;
#pragma unroll
            for (int j = 0; j < 4; ++j) { const float ea0 = fexp2(-LOG2E * acc[m][0][j]), ea1 = fexp2(-LOG2E * acc[m][1][j]), eb0 = fexp2(-LOG2E * acc[m][2][j]), eb1 = fexp2(-LOG2E * acc[m][3][j]);
                r0[j] = (1.f + eb0) * frcp(1.f + ea0); r1[j] = (1.f + eb1) * frcp(1.f + ea1); d0[j] = frcp(1.f + eb0); d1[j] = frcp(1.f + eb1); }
            const size_t off = (size_t)(row0 + m * 16) * 2048 + col0;
            __builtin_nontemporal_store(pack8(r0, r1), (u32x4*)(gsb + off)); __builtin_nontemporal_store(pack8(d0, d1), (u32x4*)(gda + off)); }
    }
};
struct EpiDown2 {
    static constexpr int NST = 8;
    unsigned char* Y;
    DI void operator()(AccQ& acc, const Unit& u, int wr4, int wc2, int fr, int fq) const {
        asm volatile("" : "+v"(fr), "+v"(fq));
        const int row0 = u.pm * BM + wr4 * 64 + fr, col0 = u.pn * HALF + wc2 * 64 + 8 * fq;
#pragma unroll
        for (int c2 = 0; c2 < 2; ++c2)
#pragma unroll
            for (int m = 0; m < 4; ++m) { const f32x4 a = acc[m][2 * c2] * 32.f, b = acc[m][2 * c2 + 1] * 32.f; u32x2 w; w.x = pk4_fp8_sat(a[0], a[1], a[2], a[3]); w.y = pk4_fp8_sat(b[0], b[1], b[2], b[3]);
                *(u32x2*)(Y + (size_t)(row0 + m * 16) * 2048 + col0 + 32 * c2) = w; }
    }
};
}

namespace att {
#define MFMA32(a, b, c) __builtin_amdgcn_mfma_f32_32x32x16_bf16((a), (b), (c), 0, 0, 0)
#define SBAR() __builtin_amdgcn_sched_barrier(0)
#define WAIT_BAR() asm volatile("s_waitcnt vmcnt(0) lgkmcnt(0)\n\ts_barrier" ::: "memory")
DI int crow(int r, int h) { return (r & 3) + 8 * (r >> 2) + 4 * h; }
DI int img_off(int row, int ch) { return 256 * row + 16 * (ch ^ (((row & 3) << 2) | ((row >> 2) & 3))); }
constexpr int TKEYS = 128, L_BUF = 65536, L_V = 32768, L_STG = 0, L_WSF = 131072 + 2048, L_FLAG = 131072 + 1024;
typedef short v4i16_t __attribute__((ext_vector_type(4)));
DI s16x4 tr16(const LAS unsigned char* p) { return __builtin_bit_cast(s16x4, __builtin_amdgcn_ds_read_tr16_b64_v4i16((LAS v4i16_t*)p)); }
template <int X> DI float swz_xor(float v) { return __uint_as_float((unsigned)__builtin_amdgcn_ds_swizzle((int)__float_as_uint(v), (X << 10) | 0x1F)); }
DI float xhalf_sum(float v) { auto rr = __builtin_amdgcn_permlane32_swap(__float_as_uint(v), __float_as_uint(v), false, false); return __uint_as_float(rr[0]) + __uint_as_float(rr[1]); }
DI float max3f(float a, float b, float c) { return __builtin_elementwise_maximum(__builtin_elementwise_maximum(a, b), c); }
DI float xhalf_max(float v) { auto rr = __builtin_amdgcn_permlane32_swap(__float_as_uint(v), __float_as_uint(v), false, false); return fmaxf(__uint_as_float(rr[0]), __uint_as_float(rr[1])); }
DI void glds16(const void* gbase, unsigned voff, unsigned lds_dst) { unsigned keep;
    asm volatile("s_nop 4\n\ts_mov_b32 %0, m0\n\ts_mov_b32 m0, %3\n\ts_nop 0\n\tglobal_load_lds_dwordx4 %1, %2\n\ts_mov_b32 m0, %0" : "=&s"(keep) : "v"(voff), "s"(gbase), "s"(lds_dst) : "memory"); }
DI void tile_offs(unsigned (&voff)[4], int wid, int lane) {
#pragma unroll
    for (int i4 = 0; i4 < 4; ++i4) { const int pc = i4 * 8 + wid, row = pc * 4 + (lane >> 4), f = ((lane >> 4) << 2) | (pc & 3); voff[i4] = (unsigned)(row * 2048 + (((lane & 15) ^ f) * 16)); }
}
template <int I0 = 0, int I1 = 4> DI void tile_issue(const bf16_t* Kt, const bf16_t* Vt, const unsigned (&voff)[4], unsigned bufaddr, int wid) {
#pragma unroll
    for (int i4 = I0; i4 < I1; ++i4) { const int pc = i4 * 8 + wid;
        glds16(Kt, voff[i4], (unsigned)__builtin_amdgcn_readfirstlane((int)(bufaddr + pc * 1024)));
        glds16(Vt, voff[i4], (unsigned)__builtin_amdgcn_readfirstlane((int)(bufaddr + L_V + pc * 1024))); }
}
DI bf16x8 kfrag(const LAS unsigned char* kimg, int kb  , int f  , int h, int sub, int st) { return *(const LAS bf16x8*)(kimg + kb + 8192 * sub + 16 * ((2 * st + h) ^ f)); }
DI bf16x8 vfrag(const LAS unsigned char* vimg, int vb  , int cx  , int q, int n, int sub, int s) {
    const int ch = (((n ^ q) << 2) | cx) * 16;
    const s16x4 lo = tr16(vimg + vb + ch + 256 * (32 * sub + 16 * s));
    const s16x4 hi = tr16(vimg + vb + (ch ^ 32) + 256 * (32 * sub + 16 * s + 8));
    return __builtin_shufflevector(lo, hi, 0, 1, 2, 3, 4, 5, 6, 7);
}
DI bf16x8 pack_p(const f32x16& p, int s) { u32x4 w; w.x = cvtpk(p[8 * s], p[8 * s + 1]); w.y = cvtpk(p[8 * s + 2], p[8 * s + 3]); w.z = cvtpk(p[8 * s + 4], p[8 * s + 5]); w.w = cvtpk(p[8 * s + 6], p[8 * s + 7]); return __builtin_bit_cast(bf16x8, w); }

DI void store_tile(const f32x16 (&o)[4], LAS unsigned char* stg, bf16_t* dst  , int ldo, int lane, int r, int h) {
#pragma unroll
    for (int i = 0; i < 16; ++i) { const int q = crow(i, h);
#pragma unroll
        for (int n = 0; n < 4; ++n) { const unsigned w = cvtpk(o[n][i], 0.f); *(LAS unsigned short*)(stg + q * 256 + (32 * n + r) * 2) = (unsigned short)w; } }
    asm volatile("s_waitcnt lgkmcnt(0)" ::: "memory");
#pragma unroll
    for (int it = 0; it < 8; ++it) { const int idx = it * 64 + lane, row = idx >> 4, ch = idx & 15; const u32x4 v = *(const LAS u32x4*)(stg + row * 256 + ch * 16);
        *(u32x4*)(dst + (size_t)row * ldo + ch * 8) = v; }
    asm volatile("s_waitcnt lgkmcnt(0)" ::: "memory");
}
struct LaneC { int r, h, kb, kfx, vb, cx, q4; };
DI LaneC lane_consts(int lane) { LaneC c; c.r = lane & 31; c.h = lane >> 5; c.kb = 256 * c.r; c.kfx = ((c.r & 3) << 2) | ((c.r >> 2) & 3);
    const int i16 = lane & 15, p4 = i16 & 3, gi = (lane >> 4) & 1; c.q4 = i16 >> 2; c.vb = 256 * (4 * c.h + c.q4) + 8 * (p4 & 1); c.cx = (2 * gi + (p4 >> 1)) ^ c.h; return c; }

template <bool DIAG> DI void sb_sub(const LAS unsigned char* kimg, const LAS unsigned char* vimg, int sub, const LaneC& c, const bf16x8 (&qf)[8], f32x16 (&o)[4], float& carry) {
    f32x16 s = {};
    bf16x8 kf[8];
#pragma unroll
    for (int st = 0; st < 8; ++st) kf[st] = kfrag(kimg, c.kb, c.kfx, c.h, sub, st);
    SBAR();
#pragma unroll
    for (int st = 0; st < 8; ++st) s = MFMA32(kf[st], qf[st], s);
    SBAR();
    float be[16], om[16];
#pragma unroll
    for (int i = 0; i < 16; ++i) { const float zt = s[i], t = fexp2(-fabsf(zt)), rr = frcp(1.f + t), sm = t * rr; const bool pos = zt >= 0.f;
        be[i] = pos ? rr : sm; om[i] = pos ? sm : rr;
        if (DIAG && !(crow(i, c.h) < c.r)) { be[i] = 0.f; om[i] = 1.f; } }
    SBAR();
    bf16x8 vf[8];
#pragma unroll
    for (int n = 0; n < 4; ++n) { vf[2 * n] = vfrag(vimg, c.vb, c.cx, c.q4, n, sub, 0); vf[2 * n + 1] = vfrag(vimg, c.vb, c.cx, c.q4, n, sub, 1); }
    float T[4]; f32x16 a;
#pragma unroll
    for (int g = 0; g < 4; ++g) { const float s2 = om[4 * g + 3], s1 = s2 * om[4 * g + 2], s0 = s1 * om[4 * g + 1]; T[g] = s0 * om[4 * g];
        a[4 * g + 3] = be[4 * g + 3]; a[4 * g + 2] = be[4 * g + 2] * s2; a[4 * g + 1] = be[4 * g + 1] * s1; a[4 * g] = be[4 * g] * s0; }
    float both[4], thi[4];
#pragma unroll
    for (int g = 0; g < 4; ++g) { auto rr = __builtin_amdgcn_permlane32_swap(__float_as_uint(T[g]), __float_as_uint(T[g]), false, false);
        thi[g] = __uint_as_float(rr[1]); both[g] = __uint_as_float(rr[0]) * thi[g]; }
    float G[4]; G[3] = carry; G[2] = G[3] * both[3]; G[1] = G[2] * both[2]; G[0] = G[1] * both[1];
#pragma unroll
    for (int g = 0; g < 4; ++g) { const float base = c.h == 0 ? G[g] * thi[g] : G[g];
#pragma unroll
        for (int k = 0; k < 4; ++k) a[4 * g + k] *= base; }
    carry = G[0] * both[0];
    const bf16x8 p0 = pack_p(a, 0), p1 = pack_p(a, 1);
    SBAR();
#pragma unroll
    for (int n = 0; n < 4; ++n) { o[n] = MFMA32(p0, vf[2 * n], o[n]); o[n] = MFMA32(p1, vf[2 * n + 1], o[n]);
    }
    SBAR();
}
DI void sb_unit(LAS unsigned char* lds, const bf16_t* Q, const bf16_t* K, const bf16_t* V, bf16_t* O  , int b, int hd, int qb, int useq) {
    int tid = threadIdx.x; asm volatile("" : "+v"(tid));
    const int lane = tid & 63, wid = __builtin_amdgcn_readfirstlane(tid >> 6); const LaneC c = lane_consts(lane);
    const size_t rowbase = (size_t)b * SEQ; const int t0 = qb * 256;
    const bf16_t* Kp = K + rowbase * 1024 + hd * 128; const bf16_t* Vp = V + rowbase * 1024 + hd * 128;
    const unsigned lbase = (unsigned)(size_t)lds;
    LAS int* flags = (LAS int*)(lds + L_FLAG + (useq & 1) * 32);
    if (lane == 0) flags[wid] = -1;
    const int jmax = 2 * qb + 1, mysub = 8 * qb + wid;
    unsigned voff[4]; tile_offs(voff, wid, lane);
    WAIT_BAR();
    tile_issue(Kp + (size_t)(TKEYS * jmax) * 1024, Vp + (size_t)(TKEYS * jmax) * 1024, voff, lbase, wid);
    bf16x8 qf[8];
    { const bf16_t* qrow = Q + (rowbase + t0 + 32 * wid + c.r) * 1024 + hd * 128 + 8 * c.h;
#pragma unroll
      for (int st = 0; st < 8; ++st) qf[st] = *(const bf16x8*)(qrow + 16 * st); }
    asm volatile("" : "+v"(qf[0]), "+v"(qf[1]), "+v"(qf[2]), "+v"(qf[3]), "+v"(qf[4]), "+v"(qf[5]), "+v"(qf[6]), "+v"(qf[7]));
    f32x16 o[4];
#pragma unroll
    for (int n = 0; n < 4; ++n) o[n] = (f32x16){};
    float carry = 1.f; int buf = 0; bool mydone = false;
    for (int j = jmax; j >= 0; --j) {
        WAIT_BAR();
        { const LAS i32x4* fl = (const LAS i32x4*)flags; const i32x4 fa = fl[0], fb = fl[1];
          const bool alldone = fa[0] > j && fa[1] > j && fa[2] > j && fa[3] > j && fb[0] > j && fb[1] > j && fb[2] > j && fb[3] > j;
          if (__builtin_amdgcn_readfirstlane((int)alldone)) break; }
        if (j > 0) tile_issue(Kp + (size_t)(TKEYS * (j - 1)) * 1024, Vp + (size_t)(TKEYS * (j - 1)) * 1024, voff, lbase + (buf ^ 1) * L_BUF, wid);
        const LAS unsigned char* kimg = lds + buf * L_BUF; const LAS unsigned char* vimg = kimg + L_V;
        if (!mydone) {
#pragma unroll
            for (int sub = 3; sub >= 0; --sub) { const int su = 4 * j + sub;
                if (su <= mysub) { if (su == mysub) sb_sub<true>(kimg, vimg, sub, c, qf, o, carry); else sb_sub<false>(kimg, vimg, sub, c, qf, o, carry); } }
            if (__all(carry == 0.f)) { mydone = true; if (lane == 0) flags[wid] = j; }
        }
        buf ^= 1;
    }
    WAIT_BAR();
    { int l2 = threadIdx.x & 63; asm volatile("" : "+v"(l2));
      store_tile(o, lds + L_STG + wid * 8192, O + (rowbase + t0 + 32 * wid) * 2048 + hd * 128, 2048, l2, l2 & 31, l2 >> 5); }
}

DI void da_rescale(f32x16 (&o)[4], LAS float* wsf, float f, int r, int h) {
    if (h == 0) wsf[r] = f;
    asm volatile("s_waitcnt lgkmcnt(0)" ::: "memory");
#pragma unroll
    for (int i = 0; i < 16; ++i) { const float fi = wsf[crow(i, h)];
#pragma unroll
        for (int n = 0; n < 4; ++n) o[n][i] *= fi; }
    asm volatile("s_waitcnt lgkmcnt(0)" ::: "memory");
}
DI void da_tile(const LAS unsigned char* kimg, const LAS unsigned char* vimg, int ci  , int mp, const LaneC& c, const bf16x8 (&qf)[4], f32x16 (&o)[4], f32x16& negm, float& m, float& l, bool& first, LAS float* wsf) {
    bf16x8 kf[8];
#pragma unroll
    for (int st = 0; st < 4; ++st) { kf[st] = kfrag(kimg, c.kb, c.kfx, c.h, 2 * ci, 4 * mp + st); kf[4 + st] = kfrag(kimg, c.kb, c.kfx, c.h, 2 * ci + 1, 4 * mp + st); }
    SBAR();
    f32x16 s0 = negm, s1 = negm;
#pragma unroll
    for (int st = 0; st < 4; ++st) { s0 = MFMA32(kf[st], qf[st], s0); s1 = MFMA32(kf[4 + st], qf[st], s1); }
    bf16x8 vf[8];
#pragma unroll
    for (int n = 0; n < 4; ++n) { vf[2 * n] = vfrag(vimg, c.vb, c.cx, c.q4, n, 2 * ci, 0); vf[2 * n + 1] = vfrag(vimg, c.vb, c.cx, c.q4, n, 2 * ci, 1); }
    SBAR();
    float rq[4];
#pragma unroll
    for (int k = 0; k < 4; ++k) { float r = max3f(s0[4 * k], s0[4 * k + 1], s0[4 * k + 2]); r = max3f(r, s0[4 * k + 3], s1[4 * k]); r = max3f(r, s1[4 * k + 1], s1[4 * k + 2]); rq[k] = max3f(r, s1[4 * k + 3], s1[4 * k + 3]); }
    float rm = max3f(max3f(rq[0], rq[1], rq[2]), rq[3], rq[3]);
    { auto rr = __builtin_amdgcn_permlane32_swap(__float_as_uint(rm), __float_as_uint(rm), false, false); rm = max3f(__uint_as_float(rr[0]), __uint_as_float(rr[1]), __uint_as_float(rr[1])); }
    if (first || __any(rm > 8.f)) {
        const float dl = first ? rm : fmaxf(rm, 0.f); m += dl;
#pragma unroll
        for (int i = 0; i < 16; ++i) { s0[i] -= dl; s1[i] -= dl; negm[i] = -m; }
        if (!first) { const float f = fexp2(-dl); l *= f; da_rescale(o, wsf, f, c.r, c.h); }
        first = false;
    }
    float acc = 0.f;
#pragma unroll
    for (int i = 0; i < 16; ++i) { s0[i] = fexp2(s0[i]); acc += s0[i]; }
    const bf16x8 p00 = pack_p(s0, 0), p01 = pack_p(s0, 1);
    SBAR();
    bf16x8 vg[8];
#pragma unroll
    for (int n = 0; n < 4; ++n) { o[n] = MFMA32(p00, vf[2 * n], o[n]); o[n] = MFMA32(p01, vf[2 * n + 1], o[n]);
        vg[2 * n] = vfrag(vimg, c.vb, c.cx, c.q4, n, 2 * ci + 1, 0); vg[2 * n + 1] = vfrag(vimg, c.vb, c.cx, c.q4, n, 2 * ci + 1, 1);
#pragma unroll
        for (int i = 4 * n; i < 4 * n + 4; ++i) { s1[i] = fexp2(s1[i]); acc += s1[i]; }
        SBAR(); }
    l += acc;
    const bf16x8 p10 = pack_p(s1, 0), p11 = pack_p(s1, 1);
    SBAR();
#pragma unroll
    for (int n = 0; n < 4; ++n) { o[n] = MFMA32(p10, vg[2 * n], o[n]); o[n] = MFMA32(p11, vg[2 * n + 1], o[n]); }
}
DI void da_unit(LAS unsigned char* lds, const bf16_t* Q, const bf16_t* K, const bf16_t* V, bf16_t* O  , const float* subg, int lamd  , int b, int hd, int qb  ) {
    int tid = threadIdx.x; asm volatile("" : "+v"(tid));
    const int lane = tid & 63, wid = __builtin_amdgcn_readfirstlane(tid >> 6), g = wid >> 1, mp = wid & 1; const LaneC c = lane_consts(lane);
    const size_t rowbase = (size_t)b * SEQ; const int t0 = qb * 128;
    const bf16_t* Kp = K + rowbase * 1024 + hd * 128; const bf16_t* Vp = V + rowbase * 1024 + hd * 128;
    const unsigned lbase = (unsigned)(size_t)lds;
    const int jlast = qb, myj = 2 * qb + (g >> 1);
    unsigned voff[4]; tile_offs(voff, wid, lane);
    WAIT_BAR();
    tile_issue(Kp, Vp, voff, lbase, wid);
    bf16x8 qf[4];
    { const bf16_t* qrow = Q + (rowbase + t0 + 32 * g + c.r) * 1024 + hd * 128 + 64 * mp + 8 * c.h;
#pragma unroll
      for (int st = 0; st < 4; ++st) qf[st] = *(const bf16x8*)(qrow + 16 * st); }
    asm volatile("" : "+v"(qf[0]), "+v"(qf[1]), "+v"(qf[2]), "+v"(qf[3]));
    LAS float* wsf = (LAS float*)(lds + L_WSF + wid * 256);
    f32x16 o[4];
#pragma unroll
    for (int n = 0; n < 4; ++n) o[n] = (f32x16){};
    float m = 0.f, l = 0.f; int buf = 0; bool first = true;
    f32x16 negm = {};
    for (int j = 0; j <= jlast; ++j) {
        WAIT_BAR();
        if (j < jlast) tile_issue<0, 2>(Kp + (size_t)(TKEYS * (j + 1)) * 1024, Vp + (size_t)(TKEYS * (j + 1)) * 1024, voff, lbase + (buf ^ 1) * L_BUF, wid);
        const LAS unsigned char* kimg = lds + buf * L_BUF;
        if (2 * j <= myj) da_tile(kimg, kimg + L_V, 0, mp, c, qf, o, negm, m, l, first, wsf);
        if (j < jlast) tile_issue<2, 4>(Kp + (size_t)(TKEYS * (j + 1)) * 1024, Vp + (size_t)(TKEYS * (j + 1)) * 1024, voff, lbase + (buf ^ 1) * L_BUF, wid);
        if (2 * j + 1 <= myj) da_tile(kimg, kimg + L_V, 1, mp, c, qf, o, negm, m, l, first, wsf);
        buf ^= 1;
    }
    WAIT_BAR();
    l = xhalf_sum(l);
    { int lb_ = lamd; asm volatile("" : "+s"(lb_)); const float lam = __uint_as_float((unsigned)lb_) + 0.2f;
      if (c.h == 0) wsf[c.r] = (mp ? lam : 1.f) * frcp(l); }
    asm volatile("s_waitcnt lgkmcnt(0)" ::: "memory");
#pragma unroll
    for (int i = 0; i < 16; ++i) { const float a = wsf[crow(i, c.h)];
#pragma unroll
        for (int n = 0; n < 4; ++n) o[n][i] *= a; }
    LAS float* stash = (LAS float*)(lds + L_STG + g * 16384);
    if (mp) {
#pragma unroll
        for (int i = 0; i < 16; ++i)
#pragma unroll
            for (int n = 0; n < 4; ++n) stash[(4 * i + n) * 64 + lane] = o[n][i];
    }
    WAIT_BAR();
    if (!mp) {
        float sg[4];
#pragma unroll
        for (int n = 0; n < 4; ++n) sg[n] = subg[32 * n + c.r] * 0.8f;
#pragma unroll
        for (int i = 0; i < 16; ++i) { float ss = 0.f;
#pragma unroll
            for (int n = 0; n < 4; ++n) { const float od = o[n][i] - stash[(4 * i + n) * 64 + lane]; o[n][i] = od; ss += od * od; }
            ss += swz_xor<1>(ss); ss += swz_xor<2>(ss); ss += swz_xor<4>(ss); ss += swz_xor<8>(ss); ss += swz_xor<16>(ss);
            const float rn = __builtin_amdgcn_rsqf(ss * (1.f / 128.f) + EPS);
#pragma unroll
            for (int n = 0; n < 4; ++n) o[n][i] *= rn * sg[n]; }
        asm volatile("s_waitcnt lgkmcnt(0)" ::: "memory");
        store_tile(o, lds + L_STG + g * 16384, O + (rowbase + t0 + 32 * g) * 2048 + 1024 + hd * 128, 2048, lane, c.r, c.h);
    }
}
#undef SBAR
#undef WAIT_BAR
}

constexpr size_t MiB = 1u << 20;
constexpr size_t WS_CTL = 0, CTL_ZERO_BYTES = 1 * MiB;
constexpr size_t WS_WINT = 1 * MiB;
constexpr size_t WS_WBRT = 41 * MiB;
constexpr size_t WS_WOUTT = 49 * MiB;
constexpr size_t WS_WGUT = 57 * MiB;
constexpr size_t WS_WDT = 185 * MiB;
constexpr size_t WS_WRT = 249 * MiB;
constexpr size_t WS_ROPE = 250 * MiB;
constexpr size_t WS_SSQ = 251 * MiB;
constexpr size_t WS_TOKINFO = 253 * MiB;
constexpr size_t WS_TOKW = WS_TOKINFO + 262144;
constexpr size_t WS_TOKPOS = WS_TOKW + 131072;
constexpr size_t WS_ROWGATE = WS_TOKPOS + 131072;
constexpr size_t WS_A = 254 * MiB;
constexpr size_t WS_B = 318 * MiB;
constexpr size_t WS_Y = 398 * MiB;
constexpr size_t WS_H = 558 * MiB;
constexpr size_t WS_END = 578 * MiB;
constexpr int CW_BAR = 4096, CW_CNT = 16384;

constexpr int RING_BYTES = 131072, LDSCTL_OFF = 147456, MISC_OFF = LDSCTL_OFF + 320, TST_OFF = LDSCTL_OFF + 512;
constexpr int LDS_BYTES = 147456 + 4096;

#define RLX_AGENT __ATOMIC_RELAXED, __HIP_MEMORY_SCOPE_AGENT
#define LDS_WAIT() asm volatile("s_waitcnt lgkmcnt(0)" ::: "memory")

#define XB_TMO      128
#define XB_XCNT(j)  (256  + 64 * (j))
#define XB_XSUB(j)  (1280 + 64 * (j))
#define XB_XGEN(j)  (2304 + 64 * (j))
#define XB_TOP      3328
#define XB_TOPGEN   3392
#define XCD_BAR_WORDS 3456
#define XB_SPIN_CAP (1u << 18)
DI unsigned xb_ld(unsigned* p)              { return __hip_atomic_load(p, __ATOMIC_RELAXED, __HIP_MEMORY_SCOPE_AGENT); }
DI unsigned xb_add(unsigned* p, unsigned v) { return __hip_atomic_fetch_add(p, v, __ATOMIC_RELAXED, __HIP_MEMORY_SCOPE_AGENT); }
DI unsigned xb_xcc_id() { return (unsigned)__builtin_amdgcn_s_getreg((3 << 11) | 20) & 0xFu; }
#define XB_SPIN(cond, bar) do { unsigned _sp = 0; while (cond) { __builtin_amdgcn_s_sleep(1); \
    if ((++_sp & 255u) == 0u) { if (xb_ld(&(bar)[XB_TMO])) break; if (_sp > XB_SPIN_CAP) { atomicAdd(&(bar)[XB_TMO], 1u); break; } } } } while (0)
struct XcdBarrier { unsigned* bar; unsigned x; volatile LAS unsigned* st; };
DI XcdBarrier xcd_barrier_post(unsigned* bar, volatile LAS unsigned* st) {
    XcdBarrier b; b.bar = bar; b.x = xb_xcc_id(); b.st = st;
    if (threadIdx.x == 0) (void)xb_add(&bar[XB_XCNT(b.x)], 1u);
    return b;
}
DI void xcd_barrier_complete(unsigned* bar, unsigned x, unsigned& nloc, unsigned& nx) {
    const unsigned G = gridDim.x * gridDim.y * gridDim.z;
    unsigned sum, cnt, mine, sp = 0u;
    for (;;) {
        sum = 0u; cnt = 0u; mine = 0u;
#pragma unroll
        for (unsigned j = 0; j < 16; ++j) { const unsigned c = xb_ld(&bar[XB_XCNT(j)]); sum += c; cnt += (c > 0u) ? 1u : 0u; mine = (j == x) ? c : mine; }
        if (sum == G) break;
        __builtin_amdgcn_s_sleep(1);
        if ((++sp & 255u) == 0u) { if (xb_ld(&bar[XB_TMO])) break; if (sp > XB_SPIN_CAP) { atomicAdd(&bar[XB_TMO], 1u); break; } }
    }
    nloc = mine > 0u ? mine : 1u; nx = cnt > 0u ? cnt : 1u;
}
DI void xcd_barrier(const XcdBarrier& b) {
    asm volatile("s_waitcnt vmcnt(0)" ::: "memory");
    __syncthreads();
    if (threadIdx.x == 0) {
        unsigned* bar = b.bar;
        __builtin_amdgcn_s_waitcnt(0);
        unsigned nloc = b.st[0], nx = b.st[1];
        if (nloc == 0u) { xcd_barrier_complete(bar, b.x, nloc, nx); b.st[0] = nloc; b.st[1] = nx; }
        const unsigned old = xb_add(&bar[XB_XSUB(b.x)], 1u);
        const unsigned gen = old / nloc;
        if (old + 1u == (gen + 1u) * nloc) {
            __builtin_amdgcn_fence(__ATOMIC_RELEASE, "agent");
            asm volatile("s_waitcnt vmcnt(0)" ::: "memory");
            const unsigned og = xb_add(&bar[XB_TOP], 1u);
            const unsigned tg = og / nx;
            if (og + 1u == (tg + 1u) * nx) xb_add(&bar[XB_TOPGEN], 1u);
            else XB_SPIN(xb_ld(&bar[XB_TOPGEN]) == tg, bar);
            __builtin_amdgcn_fence(__ATOMIC_ACQUIRE, "agent");
            asm volatile("s_waitcnt vmcnt(0)" ::: "memory");
        } else {
            XB_SPIN(xb_ld(&bar[XB_TOPGEN]) == gen, bar);
            __builtin_amdgcn_fence(__ATOMIC_ACQUIRE, "agent");
            asm volatile("s_waitcnt vmcnt(0)" ::: "memory");
        }
    }
    __syncthreads();
}

struct Args {
    const float* x; const float* mix_g; const float* w_in; const float* lq1; const float* lk1; const float* lq2; const float* lk2; const float* subg;
    const float* w_bsb; const float* w_bd; const float* w_out; const float* ffn_g; const float* w_gr; const float* w_er; const float* w_gate; const float* w_up; const float* w_down; const float* fin_g;
    float* out; unsigned char* ws;
};

template <int MODE> DI int drow_of(int n) {
    if (MODE == 1) { const int pn = n >> 8; if (pn < 12 || pn >= 20) return n; const int lc = n & 255; return (pn << 8) + 128 * ((lc >> 5) & 1) + 32 * (lc >> 6) + (lc & 31); }
    if (MODE == 2) return 256 * (n >> 7) + (n & 127);
    if (MODE == 3) return 256 * (n >> 7) + 128 + (n & 127);
    return n;
}
template <int MODE> DI void transpose_item(const float* W, int N, int k0, int n0, bf16_t* WT, int ldk, int koff, LAS unsigned char* scr, int lane) {
    const int g = lane >> 4, l16 = lane & 15;
    f32x4 v[16];
#pragma unroll
    for (int i = 0; i < 16; ++i) { const int kk = 8 * (i >> 1) + 2 * g + (i & 1); v[i] = __builtin_nontemporal_load((const f32x4*)(W + (size_t)(k0 + kk) * N + n0 + 4 * l16)); }
#pragma unroll
    for (int m = 0; m < 8; ++m)
#pragma unroll
        for (int jj = 0; jj < 4; ++jj) { const int n = 4 * l16 + jj; *(LAS unsigned*)(scr + n * 128 + (((4 * m + g) ^ ((l16 & 7) << 2)) * 4)) = cvtpk(v[2 * m][jj], v[2 * m + 1][jj]); }
    LDS_WAIT(); asm volatile("" ::: "memory");
#pragma unroll
    for (int it = 0; it < 8; ++it) { const int n = it * 8 + (lane >> 3), c = lane & 7; const u32x4 o = *(const LAS u32x4*)(scr + n * 128 + ((c ^ ((n >> 2) & 7)) * 16));
        *(u32x4*)(WT + (size_t)drow_of<MODE>(n0 + n) * ldk + koff + k0 + 8 * c) = o; }
    LDS_WAIT(); asm volatile("" ::: "memory");
}

template <int MODE> DI int drow8_of(int n) { if (MODE == 4) return 8 * (n >> 2) + (n & 3); if (MODE == 5) return 8 * (n >> 2) + 4 + (n & 3);
    if (MODE == 6) { const int t = n >> 11, cc = n & 2047; return 128 * (cc >> 6) + 64 * ((cc >> 5) & 1) + 32 * t + (cc & 31); }
    return n; }
template <int MODE> DI void transpose_item8(const float* W, int N, int k0, int n0, unsigned char* WT, int ldk, float scale, LAS unsigned char* scr, int lane) {
    const int g = lane >> 4, l16 = lane & 15;
    f32x4 v[16];
#pragma unroll
    for (int i = 0; i < 16; ++i) { const int kk = 16 * (i >> 2) + 4 * g + (i & 3); v[i] = __builtin_nontemporal_load((const f32x4*)(W + (size_t)(k0 + kk) * N + n0 + 4 * l16)); }
#pragma unroll
    for (int b = 0; b < 4; ++b)
#pragma unroll
        for (int jj = 0; jj < 4; ++jj) { const int n = 4 * l16 + jj; *(LAS unsigned*)(scr + n * 64 + (((4 * b + g) ^ l16) * 4)) = pk4_fp8(v[4 * b][jj] * scale, v[4 * b + 1][jj] * scale, v[4 * b + 2][jj] * scale, v[4 * b + 3][jj] * scale); }
    LDS_WAIT(); asm volatile("" ::: "memory");
#pragma unroll
    for (int it = 0; it < 4; ++it) { const int n = it * 16 + (lane >> 2), c = lane & 3, s = (n >> 2) & 15; u32x4 o;
#pragma unroll
        for (int t = 0; t < 4; ++t) o[t] = *(const LAS unsigned*)(scr + n * 64 + (((4 * c + t) ^ s) * 4));
        *(u32x4*)(WT + (size_t)drow8_of<MODE>(n0 + n) * ldk + k0 + 16 * c) = o; }
    LDS_WAIT(); asm volatile("" ::: "memory");
}

typedef float f32x16v __attribute__((ext_vector_type(16)));
DI void fp6_slot_store(unsigned char* rowp  , int s, const f32x16v lo, const f32x16v hi) {
    const auto d = __builtin_amdgcn_cvt_scalef32_2xpk16_fp6_f32(lo, hi, 1.0f);
    unsigned char* p = rowp + (s >> 2) * 128 + 16 * (s & 3);
    *(u32x4*)p = (u32x4){(unsigned)d[0], (unsigned)d[1], (unsigned)d[2], (unsigned)d[3]}; *(u32x2*)(p + 64) = (u32x2){(unsigned)d[4], (unsigned)d[5]};
}
DI void fp6_weight_item(const float* W, int N, int s, int n0, unsigned char* WT, float scale, int lane) {
    f32x16v lo, hi;
#pragma unroll
    for (int j = 0; j < 8; ++j)
#pragma unroll
        for (int i = 0; i < 4; ++i) { const float v = __builtin_nontemporal_load(W + (size_t)(4 * s + 256 * j + i) * N + n0 + lane) * scale; if (j < 4) lo[4 * j + i] = v; else hi[4 * (j - 4) + i] = v; }
    fp6_slot_store(WT + (size_t)drow8_of<6>(n0 + lane) * 2048, s, lo, hi);
}
DI void rms_row_bf16(const float* xrow, const f32x4 (&g)[8]  , bf16_t* orow, unsigned char* orow8, int lane) {
    const f32x4* xr = (const f32x4*)xrow + lane; f32x4 v[8]; float s = 0.f;
#pragma unroll
    for (int j = 0; j < 8; ++j) { v[j] = __builtin_nontemporal_load(xr + 64 * j); s += (v[j][0] * v[j][0] + v[j][1] * v[j][1]) + (v[j][2] * v[j][2] + v[j][3] * v[j][3]); }
    const float rs = __builtin_amdgcn_rsqf(wave_sum(s) * (1.f / DM) + EPS);
    u32x2* o8 = (u32x2*)orow + lane;
    f32x16v lo, hi;
#pragma unroll
    for (int j = 0; j < 8; ++j) { const f32x4 gg = g[j]; const float e0 = v[j][0] * rs * gg[0], e1 = v[j][1] * rs * gg[1], e2 = v[j][2] * rs * gg[2], e3 = v[j][3] * rs * gg[3];
        u32x2 w; w.x = cvtpk(e0, e1); w.y = cvtpk(e2, e3); o8[64 * j] = w;
        if (j < 4) { lo[4 * j] = 2.f * e0; lo[4 * j + 1] = 2.f * e1; lo[4 * j + 2] = 2.f * e2; lo[4 * j + 3] = 2.f * e3; } else { hi[4 * j - 16] = 2.f * e0; hi[4 * j - 15] = 2.f * e1; hi[4 * j - 14] = 2.f * e2; hi[4 * j - 13] = 2.f * e3; } }
    fp6_slot_store(orow8, lane, lo, hi);
}

constexpr int NWAVES = 8;
__global__ void __launch_bounds__(NWAVES * 64, 2) hybrid_fwd(Args args) {
    extern __shared__ __attribute__((aligned(16))) unsigned char lds_raw[];
    LAS unsigned char* lds = (LAS unsigned char*)lds_raw;
    const int tid = threadIdx.x, lane = tid & 63, wave = __builtin_amdgcn_readfirstlane(tid >> 6);
    const int G = gridDim.x, bx = blockIdx.x;
    const int vcu = (G % 8 == 0) ? (bx % 8) * (G / 8) + bx / 8 : bx;
#define KA_DECL const __attribute__((address_space(4))) Args* ka = (const __attribute__((address_space(4))) Args*)__builtin_amdgcn_kernarg_segment_ptr(); asm volatile("" : "+s"(ka)); \
    unsigned char* const ws = ka->ws; (void)ws; \
    int tid = threadIdx.x; asm volatile("" : "+v"(tid)); const int lane = tid & 63; (void)lane
#define P_WINT ((bf16_t*)(ws + WS_WINT))
#define P_WBRT ((bf16_t*)(ws + WS_WBRT))
#define P_WOUTT ((bf16_t*)(ws + WS_WOUTT))
#define P_WGUT8 ((unsigned char*)(ws + WS_WGUT))
#define P_WDT8 ((unsigned char*)(ws + WS_WDT))
#define P_WRT ((bf16_t*)(ws + WS_WRT))
#define P_ROPE ((f32x2*)(ws + WS_ROPE))
#define P_SSQ ((float*)(ws + WS_SSQ))
#define P_TOKINFO ((int*)(ws + WS_TOKINFO))
#define P_TOKW ((float*)(ws + WS_TOKW))
#define P_TOKPOS ((int*)(ws + WS_TOKPOS))
#define P_ROWGATE ((float*)(ws + WS_ROWGATE))
#define P_BUFA ((bf16_t*)(ws + WS_A))
#define P_BUFB ((bf16_t*)(ws + WS_B))
#define P_HB8 ((unsigned char*)(ws + WS_H))
#define P_XS8 ((unsigned char*)(ws + WS_B))
#define P_YB8 ((unsigned char*)(ws + WS_Y))
#define P_H8IN ((unsigned char*)(ws + (size_t)512 * MiB))
#define P_WING8 ((unsigned char*)(ws + WS_WINT + (size_t)24 * MiB))
#define P_GSB ((bf16_t*)ka->out)
#define P_GDA ((bf16_t*)ka->out + (size_t)NTOK * 2048)
#define P_CTAB ((int*)(ws + WS_CTL + 65536))
    volatile LAS unsigned* MISC = (volatile LAS unsigned*)(lds + MISC_OFF);
    LAS int* tstart = (LAS int*)(lds + TST_OFF);
    for (int u = tid; u < (LDS_BYTES - RING_BYTES) / 4; u += NWAVES * 64) ((LAS unsigned*)(lds + RING_BYTES))[u] = 0u;
    __syncthreads();
    XcdBarrier bar;
    { KA_DECL; bar = xcd_barrier_post((unsigned*)(ws + WS_CTL) + CW_BAR, MISC + 8); }
    const int gw = vcu * NWAVES + wave, NGW = G * NWAVES;

#if DBG_STAGE != 1
    if (PH(0)) for (int rep_ = 0; rep_ < kReps[0]; ++rep_) { KA_DECL;
        LAS unsigned char* scr = lds + wave * 16384;
        constexpr int I_IN = 32 * 96, I_G6 = 64 * 64, I_BR = 16 * 32, I_OUT = 32 * 32, I_G = 32 * 8, I_D = 8 * 32;
        constexpr int NITEMS = I_IN + I_G6 + 2 * I_BR + I_OUT + 32 * (2 * I_G + I_D);
        for (int it = gw; it < NITEMS; it += NGW) {
            int r = it;
            if (r < I_IN) { const int kb = r / 96, nb = r % 96; transpose_item<1>(ka->w_in, INC, 64 * kb, 64 * nb, P_WINT, 2048, 0, scr, lane); continue; } r -= I_IN;
            if (r < I_G6) { fp6_weight_item(ka->w_in + 6144, INC, r >> 6, 64 * (r & 63), P_WING8, 64.f, lane); continue; } r -= I_G6;
            if (r < I_BR) { const int kb = r / 32, nb = r % 32; transpose_item<0>(ka->w_bsb, 2048, 64 * kb, 64 * nb, P_WBRT, 2048, 0, scr, lane); continue; } r -= I_BR;
            if (r < I_BR) { const int kb = r / 32, nb = r % 32; transpose_item<0>(ka->w_bd, 2048, 64 * kb, 64 * nb, P_WBRT, 2048, 1024, scr, lane); continue; } r -= I_BR;
            if (r < I_OUT) { const int kb = r / 32, nb = r % 32; transpose_item<0>(ka->w_out, 2048, 64 * kb, 64 * nb, P_WOUTT, 2048, 0, scr, lane); continue; } r -= I_OUT;
            if (r < 32 * I_G) { const int e = r / I_G, q = r % I_G, kb = q / 8, nb = q % 8;
                transpose_item8<4>(ka->w_gate + (size_t)e * 2048 * 512, 512, 64 * kb, 64 * nb, P_WGUT8 + (size_t)e * 1024 * 2048, 2048, 64.f, scr, lane); continue; } r -= 32 * I_G;
            if (r < 32 * I_G) { const int e = r / I_G, q = r % I_G, kb = q / 8, nb = q % 8;
                transpose_item8<5>(ka->w_up + (size_t)e * 2048 * 512, 512, 64 * kb, 64 * nb, P_WGUT8 + (size_t)e * 1024 * 2048, 2048, 64.f, scr, lane); continue; } r -= 32 * I_G;
            { const int e = r / I_D, q = r % I_D, kb = q / 32, nb = q % 32;
                transpose_item8<0>(ka->w_down + (size_t)e * 512 * 2048, 2048, 64 * kb, 64 * nb, P_WDT8 + (size_t)e * 2048 * 512, 512, 32.f, scr, lane); }
        }
        for (int idx = bx * 512 + tid; idx < SEQ * 32; idx += G * 512) {
            const int pos = idx >> 5, i = idx & 31;
            const float invf = __builtin_amdgcn_exp2f(-(float)i * (13.287712379549449f / 32.f));
            const float ang = (float)pos * invf;
            double rev = (double)ang * 0.15915494309189535; rev -= __builtin_floor(rev);
            const float rf = (float)rev;
            P_ROPE[idx] = (f32x2){__builtin_amdgcn_cosf(rf), __builtin_amdgcn_sinf(rf)};
        }
        for (int idx = bx * 512 + tid; idx < 64 * 2048; idx += G * 512) {
            const int j = idx >> 11, k = idx & 2047; float v = 0.f;
            if (j < 4) v = ka->w_gr[k * 4 + j] * ka->ffn_g[k]; else if (j < 36) v = ka->w_er[k * 32 + (j - 4)] * ka->ffn_g[k];
            P_WRT[idx] = (bf16_t)(cvtpk(v, 0.f) & 0xffffu);
        }
        { f32x4 mg[8];
#pragma unroll
          for (int j = 0; j < 8; ++j) mg[j] = ((const f32x4*)ka->mix_g)[lane + 64 * j];
          for (int m = gw; m < NTOK; m += NGW) rms_row_bf16(ka->x + (size_t)m * DM, mg, P_BUFA + (size_t)m * DM, P_H8IN + (size_t)m * DM, lane); }
        xcd_barrier(bar);
    }

    if (PH(1)) for (int rep_ = 0; rep_ < kReps[1]; ++rep_) { KA_DECL;
#ifndef STAGGER_TICKS
#define STAGGER_TICKS 0
#endif
        if (STAGGER_TICKS) { const unsigned long long t0 = __builtin_amdgcn_s_memrealtime(), dl = (unsigned long long)(((bx >> 3) & 7) * STAGGER_TICKS);
            while (__builtin_amdgcn_s_memrealtime() - t0 < dl) __builtin_amdgcn_s_sleep(8); }
        { pg8::Gemm g{P_BUFA, P_WINT, NTOK, 6144, DM}; pg8::StaticOrder S; S.init(NTOK, 6144, G, bx);
          pg8::EpiInProj E{P_BUFB, P_ROPE};
          pg8::gemm_phase<pg8::EpiInProj, pg8::StaticOrder, true, true>(lds, g, S, E); }
        { pg8::Gemm g{(const bf16_t*)P_H8IN, (const bf16_t*)P_WING8, NTOK, 4096, DM / 2}; pg8::StaticOrder S; S.init(NTOK, 2 * 4096, G, bx);
          pg8::EpiGate2 E{P_GSB, P_GDA};
          pg8::gemm_f8v2_phase<pg8::EpiGate2, pg8::StaticOrder, 127 - 6, 127 - 1, 2>(lds, g, S, E); }
        xcd_barrier(bar);
    }

    if (PH(2)) for (int rep_ = 0; rep_ < kReps[2]; ++rep_) { KA_DECL;
        const float a = ka->lq1[lane] * ka->lk1[lane], b2 = ka->lq2[lane] * ka->lk2[lane];
        const int lamd = __builtin_amdgcn_readfirstlane((int)__float_as_uint(__expf(wave_sum(a)) - __expf(wave_sum(b2))));
        const bf16_t* qsb = P_BUFB; const bf16_t* ksb = P_BUFB + (size_t)NTOK * 1024; const bf16_t* vsb = P_BUFB + (size_t)2 * NTOK * 1024;
        const bf16_t* qda = P_BUFB + (size_t)3 * NTOK * 1024; const bf16_t* kda = P_BUFB + (size_t)4 * NTOK * 1024; const bf16_t* vda = P_BUFB + (size_t)5 * NTOK * 1024;
        for (int u = vcu; u < 256; u += G) {
            const int bh = u >> 2, pi = u & 3, b = bh >> 3, hd = bh & 7;
#ifndef ATT_MASK
#define ATT_MASK 3
#endif
            if (ATT_MASK & 1) for (int k = 0; k < 2 * REP_SB; ++k) att::sb_unit(lds, qsb, ksb, vsb, P_BUFA, b, hd, (k & 1) == 0 ? 7 - pi : pi, k);
            if (ATT_MASK & 2) for (int k = 0; k < 4 * REP_DA; ++k) att::da_unit(lds, qda, kda, vda, P_BUFA, ka->subg, lamd, b, hd, (k & 1) ? 2 * pi + ((k >> 1) & 1) : 15 - 2 * pi - ((k >> 1) & 1));
        }
        xcd_barrier(bar);
    }

    if (PH(3)) for (int rep_ = 0; rep_ < kReps[3]; ++rep_) { KA_DECL;
        pg8::Gemm g{P_BUFA, P_WBRT, NTOK, DM, DM}; pg8::StaticOrder S; S.init(NTOK, DM, G, bx);
        pg8::EpiMerged E{P_GSB, P_GDA, P_BUFB};
        pg8::gemm_phase<pg8::EpiMerged, pg8::StaticOrder, true, true>(lds, g, S, E);
        xcd_barrier(bar);
    }

    if (PH(4)) for (int rep_ = 0; rep_ < kReps[4]; ++rep_) { KA_DECL;
        pg8::Gemm g{P_BUFB, P_WOUTT, NTOK, DM, DM}; pg8::StaticOrder S; S.init(NTOK, DM, G, bx);
        pg8::EpiX1 E{ka->x, P_BUFA, P_SSQ};
        pg8::gemm_phase<pg8::EpiX1, pg8::StaticOrder, true, true>(lds, g, S, E);
        xcd_barrier(bar);
    }
#endif

#if DBG_STAGE == 0
    if (PH(5)) for (int rep_ = 0; rep_ < kReps[5]; ++rep_) { KA_DECL;
        constexpr int PSTR = 64 * 56;
        LAS float* part = (LAS float*)lds; LAS float* Lg = (LAS float*)(lds + 8 * PSTR * 4);
        LAS int* hist = (LAS int*)(lds + 131072);
        const int fr = lane & 15, fq = lane >> 4;
        for (int tb = bx; tb < NTOK / 64; tb += G) {
            if (tid < 32) hist[tid] = 0;
            const f32x4 sv = *(const f32x4*)(P_SSQ + (size_t)(tb * 64 + (tid >> 3)) * 32 + 4 * (tid & 7));
            bf16x8 bv[8][3];
            { const bf16_t* bp = P_WRT + (size_t)fr * DM + 256 * wave + 8 * fq;
#pragma unroll
              for (int kk = 0; kk < 8; ++kk)
#pragma unroll
                  for (int nt = 0; nt < 3; ++nt) bv[kk][nt] = *(const bf16x8*)(bp + (size_t)16 * nt * DM + 32 * kk); }
#pragma unroll 1
            for (int tp = 0; tp < 2; ++tp) {
                bf16x8 av[2][8]; f32x4 acc[2][3];
#pragma unroll
                for (int u = 0; u < 2; ++u) { const bf16_t* ap = P_BUFA + (size_t)(tb * 64 + 16 * (2 * tp + u) + fr) * DM + 256 * wave + 8 * fq;
#pragma unroll
                    for (int kk = 0; kk < 8; ++kk) av[u][kk] = *(const bf16x8*)(ap + 32 * kk);
#pragma unroll
                    for (int nt = 0; nt < 3; ++nt) acc[u][nt] = (f32x4){0.f, 0.f, 0.f, 0.f}; }
#pragma unroll
                for (int u = 0; u < 2; ++u)
#pragma unroll
                    for (int kk = 0; kk < 8; ++kk)
#pragma unroll
                        for (int nt = 0; nt < 3; ++nt) acc[u][nt] = __builtin_amdgcn_mfma_f32_16x16x32_bf16(av[u][kk], bv[kk][nt], acc[u][nt], 0, 0, 0);
#pragma unroll
                for (int u = 0; u < 2; ++u)
#pragma unroll
                    for (int nt = 0; nt < 3; ++nt)
#pragma unroll
                        for (int rg = 0; rg < 4; ++rg) part[wave * PSTR + (16 * (2 * tp + u) + 4 * fq + rg) * 56 + 16 * nt + fr] = acc[u][nt][rg];
            }
            __syncthreads();
            { const int t = tid >> 3, j = tid & 7;
              float ss = (sv[0] + sv[1]) + (sv[2] + sv[3]);
              ss += swzx<1>(ss); ss += swzx<2>(ss); ss += swzx<4>(ss);
              const float rsv = __builtin_amdgcn_rsqf(ss * (1.f / DM) + EPS);
#pragma unroll
              for (int i = 0; i < 6; ++i) { float v = 0.f;
#pragma unroll
                  for (int w = 0; w < 8; ++w) v += part[w * PSTR + t * 56 + j + 8 * i];
                  Lg[t * 64 + j + 8 * i] = v * rsv; } }
            __syncthreads();
            int ex0 = 0, ex1 = 0, lr0 = 0, lr1 = 0; float w0 = 0.f, w1 = 0.f; const bool router = (wave < 4 && lane < 16); const int tok0 = tb * 64 + 16 * wave;
            { LAS float* lg = Lg + 16 * wave * 64;
            if (router) {
                const LAS float* L = lg + lane * 64;
                float g0 = L[0]; int grp = 0;
#pragma unroll
                for (int j = 1; j < 4; ++j) { const float v = L[j]; if (v > g0) { g0 = v; grp = j; } }
                float den = 0.f;
#pragma unroll
                for (int j = 0; j < 4; ++j) den += __expf(L[j] - g0);
                const float pg = 1.f / den;
                const LAS float* E = L + 4 + 8 * grp;
                float v0 = E[0]; int i0 = 0;
#pragma unroll
                for (int j = 1; j < 8; ++j) { const float v = E[j]; if (v > v0) { v0 = v; i0 = j; } }
                float v1 = -3.0e38f; int i1 = 0;
#pragma unroll
                for (int j = 0; j < 8; ++j) { const float v = E[j]; if (j != i0 && v > v1) { v1 = v; i1 = j; } }
                const float e1 = __expf(v1 - v0); w0 = pg / (1.f + e1); w1 = pg * e1 / (1.f + e1);
                ex0 = grp * 8 + i0; ex1 = grp * 8 + i1;
                lr0 = __hip_atomic_fetch_add(hist + ex0, 1, __ATOMIC_RELAXED, __HIP_MEMORY_SCOPE_WORKGROUP); lr1 = __hip_atomic_fetch_add(hist + ex1, 1, __ATOMIC_RELAXED, __HIP_MEMORY_SCOPE_WORKGROUP);
            }
            LDS_WAIT(); asm volatile("" ::: "memory");
            }
            if (router) { const int t = tok0 + lane;
                *(int4*)(P_TOKINFO + 4 * (size_t)t) = make_int4(ex0, lr0, ex1, lr1);
                *(float2*)(P_TOKW + 2 * (size_t)t) = make_float2(w0, w1); }
            __syncthreads();
            if (tid < 32) P_CTAB[tb * 32 + tid] = hist[tid];
            __syncthreads();
        }
        xcd_barrier(bar);
    }

    if (PH(6)) for (int rep_ = 0; rep_ < kReps[6]; ++rep_) { KA_DECL;
        LAS int* ptab = (LAS int*)lds;
        static_assert(NTOK / 64 == 256, "one wave scans 256 blocks as 64 lanes x 4");
#pragma unroll
        for (int k = 0; k < 4; ++k) { const int e = 4 * wave + k;
            const int v0 = P_CTAB[(4 * lane) * 32 + e], v1 = P_CTAB[(4 * lane + 1) * 32 + e], v2 = P_CTAB[(4 * lane + 2) * 32 + e], v3 = P_CTAB[(4 * lane + 3) * 32 + e];
            const int s0 = v0, s1 = s0 + v1, s2 = s1 + v2, s3 = s2 + v3; int incl = s3;
#pragma unroll
            for (int d = 1; d < 64; d <<= 1) { const int n = __shfl_up(incl, d); if (lane >= d) incl += n; }
            const int ex = incl - s3;
            *(LAS i32x4*)(ptab + e * 256 + 4 * lane) = (i32x4){ex, ex + s0, ex + s1, ex + s2};
            if (lane == 63) ptab[8192 + e] = incl; }
        __syncthreads();
        if (wave == 0) { const int cnt = (lane < 32) ? (ptab[8192 + (lane & 31)] + 255) >> 8 : 0; int incl = cnt;
#pragma unroll
            for (int d = 1; d < 32; d <<= 1) { const int n = __shfl_up(incl, d); if (lane >= d) incl += n; }
            if (lane < 32) tstart[lane] = incl - cnt;
            if (lane == 31) tstart[32] = incl; }
        __syncthreads();
        f32x4 gq[8];
#pragma unroll
        for (int q = 0; q < 8; ++q) gq[q] = ((const f32x4*)ka->ffn_g + 8 * lane)[q];
        for (int t0 = gw; t0 < NTOK; t0 += 2 * NGW) {
            const int tt[2] = {t0, (t0 + NGW < NTOK) ? t0 + NGW : t0};
            int4 ti[2]; float sq[2]; u32x4 xv[2][4];
#pragma unroll
            for (int u = 0; u < 2; ++u) { ti[u] = *(const int4*)(P_TOKINFO + 4 * (size_t)tt[u]); sq[u] = (lane < 32) ? P_SSQ[(size_t)tt[u] * 32 + lane] : 0.f;
                const u32x4* src = (const u32x4*)(P_BUFA + (size_t)tt[u] * DM) + 4 * lane;
#pragma unroll
                for (int q = 0; q < 4; ++q) xv[u][q] = src[q]; }
#pragma unroll
            for (int u = 0; u < 2; ++u) {
                const int pb = tt[u] >> 6, pos0 = 256 * tstart[ti[u].x] + ptab[ti[u].x * 256 + pb] + ti[u].y, pos1 = 256 * tstart[ti[u].z] + ptab[ti[u].z * 256 + pb] + ti[u].w;
                const float rs = __builtin_amdgcn_rsqf(wave_sum(sq[u]) * (1.f / DM) + EPS);
                u32x4 o[2];
#pragma unroll
                for (int q = 0; q < 4; ++q) { const u32x4 v = xv[u][q]; const f32x4 g0 = gq[2 * q], g1 = gq[2 * q + 1];
                    const unsigned w0 = pk4_fp8_sat(bflo(v.x) * rs * g0[0], bfhi(v.x) * rs * g0[1], bflo(v.y) * rs * g0[2], bfhi(v.y) * rs * g0[3]);
                    const unsigned w1 = pk4_fp8_sat(bflo(v.z) * rs * g1[0], bfhi(v.z) * rs * g1[1], bflo(v.w) * rs * g1[2], bfhi(v.w) * rs * g1[3]);
                    o[q >> 1][(q & 1) * 2] = w0; o[q >> 1][(q & 1) * 2 + 1] = w1; }
                { u32x4* d0 = (u32x4*)(P_XS8 + (size_t)pos0 * DM) + 2 * lane; u32x4* d1 = (u32x4*)(P_XS8 + (size_t)pos1 * DM) + 2 * lane; d0[0] = o[0]; d0[1] = o[1]; d1[0] = o[0]; d1[1] = o[1]; }
                if (lane == 0) *(int2*)(P_TOKPOS + 2 * (size_t)tt[u]) = make_int2(pos0, pos1);
            }
        }
        xcd_barrier(bar);
    }

    if (PH(7)) for (int rep_ = 0; rep_ < kReps[7]; ++rep_) { KA_DECL;
        pg8::Gemm g{(const bf16_t*)P_XS8, (const bf16_t*)P_WGUT8, PROWS, 1024, DM / 2}; pg8::MoeOrder S{tstart, 8, G, bx};
        pg8::EpiSwiglu2 E{P_HB8};
        pg8::gemm_f8v2_phase<pg8::EpiSwiglu2, pg8::MoeOrder, 127 - 6, 127>(lds, g, S, E);
        xcd_barrier(bar);
    }

    if (PH(8)) for (int rep_ = 0; rep_ < kReps[8]; ++rep_) { KA_DECL;
        pg8::Gemm g{(const bf16_t*)P_HB8, (const bf16_t*)P_WDT8, PROWS, 2048, DE / 2}; pg8::MoeOrder S{tstart, 16, G, bx};
        pg8::EpiDown2 E{P_YB8};
        pg8::gemm_f8v2_phase<pg8::EpiDown2, pg8::MoeOrder, 127 - 5, 127>(lds, g, S, E);
        xcd_barrier(bar);
    }
#endif

    if (PH(9)) for (int rep_ = 0; rep_ < kReps[9]; ++rep_) { KA_DECL;
    f32x4 fg[8];
#pragma unroll
    for (int j = 0; j < 8; ++j) fg[j] = ((const f32x4*)ka->fin_g)[lane + 64 * j];
#if DBG_STAGE == 0
    for (int t0 = gw; t0 < NTOK; t0 += 2 * NGW) {
        const int tt[2] = {t0, (t0 + NGW < NTOK) ? t0 + NGW : t0};
        u32x2 xw[2][8]; unsigned ya[2][8], yb[2][8]; float wa[2], wb[2];
#pragma unroll
        for (int u = 0; u < 2; ++u) { const int2 tp = *(const int2*)(P_TOKPOS + 2 * (size_t)tt[u]); const float2 tw = *(const float2*)(P_TOKW + 2 * (size_t)tt[u]); wa[u] = tw.x * (1.f / 32.f); wb[u] = tw.y * (1.f / 32.f);
            const u32x2* xr = (const u32x2*)(P_BUFA + (size_t)tt[u] * DM) + lane; const unsigned* pa = (const unsigned*)(P_YB8 + (size_t)tp.x * DM) + lane; const unsigned* pb = (const unsigned*)(P_YB8 + (size_t)tp.y * DM) + lane;
#pragma unroll
            for (int j = 0; j < 8; ++j) { xw[u][j] = xr[64 * j]; ya[u][j] = pa[64 * j]; yb[u][j] = pb[64 * j]; } }
#pragma unroll
        for (int u = 0; u < 2; ++u) { f32x4 v[8]; float s = 0.f;
#pragma unroll
            for (int j = 0; j < 8; ++j) { const u32x2 w = xw[u][j]; const int a = (int)ya[u][j], b = (int)yb[u][j];
                const f32x2 a0 = __builtin_amdgcn_cvt_pk_f32_fp8(a, false), a1 = __builtin_amdgcn_cvt_pk_f32_fp8(a, true), b0 = __builtin_amdgcn_cvt_pk_f32_fp8(b, false), b1 = __builtin_amdgcn_cvt_pk_f32_fp8(b, true);
                v[j] = (f32x4){bflo(w.x) + (a0[0] * wa[u] + b0[0] * wb[u]), bfhi(w.x) + (a0[1] * wa[u] + b0[1] * wb[u]), bflo(w.y) + (a1[0] * wa[u] + b1[0] * wb[u]), bfhi(w.y) + (a1[1] * wa[u] + b1[1] * wb[u])};
                s += (v[j][0] * v[j][0] + v[j][1] * v[j][1]) + (v[j][2] * v[j][2] + v[j][3] * v[j][3]); }
            const float rs = __builtin_amdgcn_rsqf(wave_sum(s) * (1.f / DM) + EPS);
            if (u == 0 || tt[1] != tt[0]) { f32x4* orow = (f32x4*)(ka->out + (size_t)tt[u] * DM) + lane;
#pragma unroll
                for (int j = 0; j < 8; ++j) orow[64 * j] = v[j] * rs * fg[j]; } }
    }
#else
    for (int t = gw; t < NTOK; t += NGW) {
        f32x4 v[8];
#if DBG_STAGE == 1
        { const f32x4* xr = (const f32x4*)(ka->x + (size_t)t * DM) + lane;
#pragma unroll
          for (int j = 0; j < 8; ++j) v[j] = xr[64 * j]; }
#else
        { const u32x2* xr = (const u32x2*)(P_BUFA + (size_t)t * DM) + lane;
#if DBG_STAGE == 0
          const int2 tp = *(const int2*)(P_TOKPOS + 2 * (size_t)t); const float2 tw = *(const float2*)(P_TOKW + 2 * (size_t)t); const float wa = tw.x * (1.f / 32.f), wb = tw.y * (1.f / 32.f);
          const unsigned* ya = (const unsigned*)(P_YB8 + (size_t)tp.x * DM) + lane; const unsigned* yb = (const unsigned*)(P_YB8 + (size_t)tp.y * DM) + lane;
#endif
#pragma unroll
          for (int j = 0; j < 8; ++j) { const u32x2 w = xr[64 * j]; v[j] = (f32x4){bflo(w.x), bfhi(w.x), bflo(w.y), bfhi(w.y)};
#if DBG_STAGE == 0
              const int a = (int)ya[64 * j], b = (int)yb[64 * j];
              const f32x2 a0 = __builtin_amdgcn_cvt_pk_f32_fp8(a, false), a1 = __builtin_amdgcn_cvt_pk_f32_fp8(a, true), b0 = __builtin_amdgcn_cvt_pk_f32_fp8(b, false), b1 = __builtin_amdgcn_cvt_pk_f32_fp8(b, true);
              v[j] += (f32x4){a0[0] * wa + b0[0] * wb, a0[1] * wa + b0[1] * wb, a1[0] * wa + b1[0] * wb, a1[1] * wa + b1[1] * wb};
#endif
          } }
#endif
        float s = 0.f;
#pragma unroll
        for (int j = 0; j < 8; ++j) s += (v[j][0] * v[j][0] + v[j][1] * v[j][1]) + (v[j][2] * v[j][2] + v[j][3] * v[j][3]);
        const float rs = __builtin_amdgcn_rsqf(wave_sum(s) * (1.f / DM) + EPS);
        f32x4* orow = (f32x4*)(ka->out + (size_t)t * DM) + lane;
#pragma unroll
        for (int j = 0; j < 8; ++j) orow[64 * j] = v[j] * rs * fg[j];
    }
#endif
}
}

extern "C" void kernel_launch(void* const* d_in, const int* in_sizes, int n_in, void* d_out, int out_size, void* d_ws, size_t ws_size, hipStream_t stream) {
    static int grid = 0;
    if (grid == 0) {
        if (n_in != 18 || in_sizes[0] != NTOK * DM || out_size != NTOK * DM || ws_size < WS_END) {
            fprintf(stderr, "kernel_launch: unexpected shapes (n_in %d, in0 %d, out %d, ws %zu)\n", n_in, n_in > 0 ? in_sizes[0] : -1, out_size, ws_size); grid = -1; return; }
        int dev = 0, cus = 0;
        if (hipGetDevice(&dev) != hipSuccess || hipDeviceGetAttribute(&cus, hipDeviceAttributeMultiprocessorCount, dev) != hipSuccess) { grid = -1; return; }
        if (hipFuncSetAttribute((const void*)hybrid_fwd, hipFuncAttributeMaxDynamicSharedMemorySize, LDS_BYTES) != hipSuccess) { fprintf(stderr, "kernel_launch: hipFuncSetAttribute failed\n"); grid = -1; return; }
        int per_cu = 0;
        if (hipOccupancyMaxActiveBlocksPerMultiprocessor(&per_cu, (const void*)hybrid_fwd, NWAVES * 64, LDS_BYTES) != hipSuccess || per_cu < 1) { fprintf(stderr, "kernel_launch: occupancy query says %d\n", per_cu); }
        (void)hipGetLastError();
        grid = cus;
    }
    if (grid < 0) return;
    if (hipMemsetAsync((char*)d_ws + WS_CTL, 0, CTL_ZERO_BYTES, stream) != hipSuccess) return;
    Args a{};
    a.x = (const float*)d_in[0]; a.mix_g = (const float*)d_in[1]; a.w_in = (const float*)d_in[2]; a.lq1 = (const float*)d_in[3]; a.lk1 = (const float*)d_in[4];
    a.lq2 = (const float*)d_in[5]; a.lk2 = (const float*)d_in[6]; a.subg = (const float*)d_in[7]; a.w_bsb = (const float*)d_in[8]; a.w_bd = (const float*)d_in[9];
    a.w_out = (const float*)d_in[10]; a.ffn_g = (const float*)d_in[11]; a.w_gr = (const float*)d_in[12]; a.w_er = (const float*)d_in[13]; a.w_gate = (const float*)d_in[14];
    a.w_up = (const float*)d_in[15]; a.w_down = (const float*)d_in[16]; a.fin_g = (const float*)d_in[17];
    a.out = (float*)d_out; a.ws = (unsigned char*)d_ws;
    hipLaunchKernelGGL(hybrid_fwd, dim3(grid), dim3(NWAVES * 64), LDS_BYTES, stream, a);
}
```
